# Optimizing an MI355X kernel written in HIP

```python
import jax, jax.numpy as jnp
from jax import lax
import numpy as np

D_MODEL = 4096
BATCH = 2
SEQ = 8192
DEPTH = 1
DEC_BATCH = 2
DEC_SEQ = 4096
PAST_LEN = 128

HEAD_DIM = 128
N_HEADS_A = 16
N_HEADS_B = 16
WIDTH_A = N_HEADS_A * HEAD_DIM
WIDTH_B = N_HEADS_B * HEAD_DIM
MIX_WIDTH = WIDTH_A + WIDTH_B
D_FF = 11008
DILATED_CONFIGS = ((128, 1), (512, 4), (2048, 16))
BLK = 128
ROPE_THETA = 500000.0
ROT_DIM = HEAD_DIM // 4
GRID_W = 64
WIN_ROWS = 8
WIN_COLS = 16
NORM_EPS = 1e-6
NEG_INF = -1e30

kernel_name = "hybrid_dilated_neighbourhood_encoder"


def _rmsnorm(x, g):
    xf = x.astype(jnp.float32)
    y = xf * lax.rsqrt(jnp.mean(xf * xf, axis=-1, keepdims=True) + NORM_EPS)
    return (y * g.astype(jnp.float32)).astype(x.dtype)


def _swiglu(x, w_gate, w_up, w_down):
    return (jax.nn.silu(x @ w_gate) * (x @ w_up)) @ w_down


def _rope_partial(x):
    T = x.shape[1]
    pos = jnp.arange(T, dtype=jnp.float32)
    inv = ROPE_THETA ** (-jnp.arange(0, ROT_DIM, 2, dtype=jnp.float32) / ROT_DIM)
    ang = pos[:, None] * inv[None, :]
    cos = jnp.cos(ang)[None, :, None, :]
    sin = jnp.sin(ang)[None, :, None, :]
    xf = x.astype(jnp.float32)
    x1 = xf[..., :ROT_DIM // 2]
    x2 = xf[..., ROT_DIM // 2:ROT_DIM]
    out = jnp.concatenate([x1 * cos - x2 * sin, x2 * cos + x1 * sin, xf[..., ROT_DIM:]], axis=-1)
    return out.astype(x.dtype)


def _window_partials(q, k, v, half):
    B, G, L, H, dh = q.shape
    Lp = ((L + BLK - 1) // BLK) * BLK
    nb = Lp // BLK
    qb = jnp.pad(q, ((0, 0), (0, 0), (0, Lp - L), (0, 0), (0, 0))).reshape(B, G, nb, BLK, H, dh)
    pad = ((0, 0), (0, 0), (BLK, Lp - L + BLK), (0, 0), (0, 0))
    kp = jnp.pad(k, pad).reshape(B, G, nb + 2, BLK, H, dh)
    vp = jnp.pad(v, pad).reshape(B, G, nb + 2, BLK, H, dh)
    kn = jnp.concatenate([kp[:, :, :-2], kp[:, :, 1:-1], kp[:, :, 2:]], axis=3)
    vn = jnp.concatenate([vp[:, :, :-2], vp[:, :, 1:-1], vp[:, :, 2:]], axis=3)
    blk = jnp.arange(nb)[:, None] * BLK
    qpos = blk + jnp.arange(BLK)[None, :]
    kpos = blk - BLK + jnp.arange(3 * BLK)[None, :]
    valid_k = (kpos >= 0) & (kpos < L)
    mask = (jnp.abs(qpos[:, :, None] - kpos[:, None, :]) <= half) & valid_k[:, None, :]
    s = jnp.einsum('bgnqhd,bgnkhd->bgnhqk', qb, kn).astype(jnp.float32) * (HEAD_DIM ** -0.5)
    s = jnp.where(mask[None, None, :, None], s, NEG_INF)
    m = jnp.max(s, axis=-1)
    p = jnp.exp(s - m[..., None])
    den = jnp.sum(p, axis=-1)
    o = jnp.einsum('bgnhqk,bgnkhd->bgnqhd', p.astype(v.dtype), vn).astype(jnp.float32)
    o = o / jnp.swapaxes(den, -1, -2)[..., None]
    o = o.reshape(B, G, Lp, H, dh)[:, :, :L]
    m = jnp.swapaxes(m, -1, -2).reshape(B, G, Lp, H)[:, :, :L]
    den = jnp.swapaxes(den, -1, -2).reshape(B, G, Lp, H)[:, :, :L]
    return o, m, den


def _dilated_attention(q, k, v):
    B, T, H, dh = q.shape
    outs, ms, dens = [], [], []
    for window, dil in DILATED_CONFIGS:
        half = window // (2 * dil)
        L = T // dil

        def strided(x):
            return x.reshape(B, L, dil, H, dh).transpose(0, 2, 1, 3, 4)

        o, m, den = _window_partials(strided(q), strided(k), strided(v), half)
        outs.append(o.transpose(0, 2, 1, 3, 4).reshape(B, T, H, dh))
        ms.append(m.transpose(0, 2, 1, 3).reshape(B, T, H))
        dens.append(den.transpose(0, 2, 1, 3).reshape(B, T, H))
    m_all = jnp.stack(ms)
    den_all = jnp.stack(dens)
    o_all = jnp.stack(outs)
    w = den_all * jnp.exp(m_all - jnp.max(m_all, axis=0, keepdims=True))
    o = jnp.sum(w[..., None] * o_all, axis=0) / jnp.sum(w, axis=0)[..., None]
    return o.astype(q.dtype)


def _neighbourhood_attention(q, k, v, rel_bias):
    B, T, H, dh = q.shape
    rows = T // GRID_W
    wr = min(WIN_ROWS, rows)
    r = jnp.arange(rows)
    rs = jnp.clip(r - wr // 2, 0, rows - wr)
    row_idx = rs[:, None] + jnp.arange(wr)[None, :]
    c = jnp.arange(GRID_W)
    cs = jnp.clip(c - WIN_COLS // 2, 0, GRID_W - WIN_COLS)
    col_mask = (c[None, :] >= cs[:, None]) & (c[None, :] < cs[:, None] + WIN_COLS)
    qg = q.reshape(B, rows, GRID_W, H, dh)
    kr = k.reshape(B, rows, GRID_W, H, dh)[:, row_idx]
    vr = v.reshape(B, rows, GRID_W, H, dh)[:, row_idx]
    s = jnp.einsum('brqhd,brjkhd->brhqjk', qg, kr).astype(jnp.float32) * (HEAD_DIM ** -0.5)
    dr = row_idx - r[:, None] + (WIN_ROWS - 1)
    dc = jnp.clip(c[None, :] - c[:, None], -(WIN_COLS - 1), WIN_COLS - 1) + (WIN_COLS - 1)
    b = rel_bias.astype(jnp.float32)[:, dr]
    b = b[:, :, :, dc].transpose(1, 0, 3, 2, 4)
    s = s + b[None]
    s = jnp.where(col_mask[None, None, None, :, None, :], s, NEG_INF)
    p = jax.nn.softmax(s.reshape(B, rows, H, GRID_W, wr * GRID_W), axis=-1)
    p = p.reshape(B, rows, H, GRID_W, wr, GRID_W).astype(v.dtype)
    o = jnp.einsum('brhqjk,brjkhd->brqhd', p, vr)
    return o.reshape(B, T, H, dh)


def _layer(h, ffn1_norm, ffn1_w_gate, ffn1_w_up, ffn1_w_down, mix_norm, w_in, nbr_rel_bias,
           out_norm_a, out_norm_b, w_out, ffn2_norm, ffn2_w_gate, ffn2_w_up, ffn2_w_down):
    B, T, _ = h.shape
    h = h + 0.5 * _swiglu(_rmsnorm(h, ffn1_norm), ffn1_w_gate, ffn1_w_up, ffn1_w_down)
    u = _rmsnorm(h, mix_norm)
    qkv = u @ w_in
    splits = [WIDTH_A, 2 * WIDTH_A, 3 * WIDTH_A, 3 * WIDTH_A + WIDTH_B, 3 * WIDTH_A + 2 * WIDTH_B]
    qa, ka, va, qb, kb, vb = jnp.split(qkv, splits, axis=-1)
    heads_a = lambda t: t.reshape(B, T, N_HEADS_A, HEAD_DIM)
    heads_b = lambda t: t.reshape(B, T, N_HEADS_B, HEAD_DIM)
    qa, ka, va = _rope_partial(heads_a(qa)), _rope_partial(heads_a(ka)), heads_a(va)
    oa = _dilated_attention(qa, ka, va).reshape(B, T, WIDTH_A)
    ob = _neighbourhood_attention(heads_b(qb), heads_b(kb), heads_b(vb), nbr_rel_bias).reshape(B, T, WIDTH_B)
    merged = jnp.concatenate([_rmsnorm(oa, out_norm_a), _rmsnorm(ob, out_norm_b)], axis=-1)
    h = h + merged @ w_out
    h = h + 0.5 * _swiglu(_rmsnorm(h, ffn2_norm), ffn2_w_gate, ffn2_w_up, ffn2_w_down)
    return h


def setup_inputs(seed: int = 0) -> dict:
    key = jax.random.key(seed)
    ks = jax.random.split(key, 20)
    f32 = jnp.float32

    def normal(k, shape, scale):
        return jax.random.normal(k, shape, f32) * scale

    def gain(k, width):
        return 1.0 + 0.01 * jax.random.normal(k, (DEPTH, width), f32)

    return {
        "x_prompt": jax.random.normal(ks[0], (BATCH, SEQ, D_MODEL), f32),
        "x_sample": jax.random.normal(ks[1], (DEC_BATCH, DEC_SEQ, D_MODEL), f32),
        "ffn1_norm": gain(ks[2], D_MODEL),
        "ffn1_w_gate": normal(ks[3], (DEPTH, D_MODEL, D_FF), D_MODEL ** -0.5),
        "ffn1_w_up": normal(ks[4], (DEPTH, D_MODEL, D_FF), D_MODEL ** -0.5),
        "ffn1_w_down": normal(ks[5], (DEPTH, D_FF, D_MODEL), D_FF ** -0.5),
        "mix_norm": gain(ks[6], D_MODEL),
        "w_in": normal(ks[7], (DEPTH, D_MODEL, 3 * MIX_WIDTH), D_MODEL ** -0.5),
        "nbr_rel_bias": normal(ks[8], (DEPTH, N_HEADS_B, 2 * WIN_ROWS - 1, 2 * WIN_COLS - 1), 0.1),
        "out_norm_a": gain(ks[9], WIDTH_A),
        "out_norm_b": gain(ks[10], WIDTH_B),
        "w_out": normal(ks[11], (DEPTH, MIX_WIDTH, D_MODEL), MIX_WIDTH ** -0.5),
        "ffn2_norm": gain(ks[12], D_MODEL),
        "ffn2_w_gate": normal(ks[13], (DEPTH, D_MODEL, D_FF), D_MODEL ** -0.5),
        "ffn2_w_up": normal(ks[14], (DEPTH, D_MODEL, D_FF), D_MODEL ** -0.5),
        "ffn2_w_down": normal(ks[15], (DEPTH, D_FF, D_MODEL), D_FF ** -0.5),
        "final_norm": 1.0 + 0.01 * jax.random.normal(ks[16], (D_MODEL,), f32),
    }


def reference(x_prompt, x_sample, ffn1_norm, ffn1_w_gate, ffn1_w_up, ffn1_w_down, mix_norm, w_in,
              nbr_rel_bias, out_norm_a, out_norm_b, w_out, ffn2_norm, ffn2_w_gate, ffn2_w_up,
              ffn2_w_down, final_norm):
    def run(x):
        h = x
        for layer in range(DEPTH):
            h = _layer(h, ffn1_norm[layer], ffn1_w_gate[layer], ffn1_w_up[layer], ffn1_w_down[layer],
                       mix_norm[layer], w_in[layer], nbr_rel_bias[layer], out_norm_a[layer],
                       out_norm_b[layer], w_out[layer], ffn2_norm[layer], ffn2_w_gate[layer],
                       ffn2_w_up[layer], ffn2_w_down[layer])
        return _rmsnorm(h, final_norm)

    y_prompt = run(x_prompt)
    y_sample = run(x_sample)
    return (y_prompt, y_sample)
```

```cpp
#include <hip/hip_runtime.h>
#include <cstdio>
#include <cstdint>

namespace pg8 {
#define PG8_LAS __attribute__((address_space(3)))
typedef unsigned short bf16_t;
typedef short bf16x8 __attribute__((ext_vector_type(8)));
typedef float f32x4 __attribute__((ext_vector_type(4)));
typedef unsigned u32x4 __attribute__((ext_vector_type(4)));
constexpr int BM = 256, BK = 64, HALF = 128, HTB = HALF * BK * 2  , STAGE_BYTES = 8 * HTB, NXCD = 8, WGM = 8;

__host__ __device__ __forceinline__ int lds_byte(int r, int c) { const int st = (r >> 4) * 2 + (c >> 5), rr = r & 15, cc = c & 31, ob = rr * 64 + cc * 2; return st * 1024 + (ob ^ (((ob >> 9) & 1) << 5)); }
__host__ __device__ __forceinline__ void stage_rc(int b, int& R, int& C) { const int st = b / 1024, sb = b % 1024, swz = sb ^ (((sb >> 9) & 1) << 5); R = (st >> 1) * 16 + swz / 64; C = (st & 1) * 32 + (swz % 64) / 2; }
__host__ __device__ __forceinline__ int perm32(int rho) { const int n = rho >> 4, i = rho & 15; return 8 * (i >> 2) + 4 * n + (i & 3); }

struct Unit { int pm, pn; };
struct Gemm { const bf16_t* A; const bf16_t* Bt; int M, N, K; };

struct StaticOrder {
    int nM, nN, nwg, G, c;
    __host__ __device__ void init(int M, int N, int G_, int c_) { nM = M / BM; nN = N / BM; nwg = nM * nN; G = G_; c = c_; }
    __host__ __device__ bool next(int i, Unit& u) const {
        const long L = (long)i * G + c; if (L >= nwg) return false;
        int wgid = (int)L; { const int q = nwg / NXCD, r = nwg % NXCD, xcd = wgid % NXCD, off = wgid / NXCD; wgid = (xcd < r ? xcd * (q + 1) : r * (q + 1) + (xcd - r) * q) + off; }
        const int nig = WGM * nN, gid = wgid / nig, fm = gid * WGM, gsz = (nM - fm) < WGM ? (nM - fm) : WGM;
        u.pm = fm + ((wgid % nig) % gsz); u.pn = (wgid % nig) / gsz; return true;
    }
    __device__ __forceinline__ void a_ready(const Unit&) const {}
    __device__ __forceinline__ void done(const Unit&) const {}
};

__device__ __forceinline__ unsigned cvt_pk_bf16(float lo, float hi) { unsigned r; asm volatile("v_cvt_pk_bf16_f32 %0, %1, %2" : "=v"(r) : "v"(lo), "v"(hi)); return r; }

struct EpiSwiGLU {
    static constexpr bool PERM = true, AFTER_DRAIN = false;
    bf16_t* O; int ldc;
    __device__ __forceinline__ void operator()(const f32x4 (&acc)[2][2][4][2], const Unit& u, int wr, int wc, int fr, int fq) const {
        const int row0 = u.pm * BM + wr * 64 + fr, col0 = u.pn * HALF + wc * 32 + 8 * fq;
#pragma unroll
        for (int ai = 0; ai < 2; ++ai)
#pragma unroll
            for (int m = 0; m < 4; ++m) { bf16_t* rowp = O + (size_t)(row0 + ai * HALF + m * 16) * ldc + col0;
                float hv[8];
#pragma unroll
                for (int n = 0; n < 2; ++n)
#pragma unroll
                    for (int i = 0; i < 4; ++i) { const float g = acc[ai][0][m][n][i], up = acc[ai][1][m][n][i];
                        const float e = __builtin_amdgcn_exp2f(g * -1.4426950408889634f); hv[4 * n + i] = g * __builtin_amdgcn_rcpf(1.0f + e) * up; }
                u32x4 w; w.x = cvt_pk_bf16(hv[0], hv[1]); w.y = cvt_pk_bf16(hv[2], hv[3]); w.z = cvt_pk_bf16(hv[4], hv[5]); w.w = cvt_pk_bf16(hv[6], hv[7]);
                *(u32x4*)rowp = w; }
    }
};
struct EpiRes {
    static constexpr bool PERM = false, AFTER_DRAIN = false;
    const float* base0; const float* base1; int split; float* out; int ldc; float alpha;
    __device__ __forceinline__ void operator()(const f32x4 (&acc)[2][2][4][2], const Unit& u, int wr, int wc, int fr, int fq) const {
        const int col0 = u.pn * BM + wc * 32 + 4 * fq; const int r0 = u.pm * BM;
        const float* bb = (r0 < split) ? base0 + (size_t)r0 * ldc : base1 + (size_t)(r0 - split) * ldc;
        float* ob = out + (size_t)r0 * ldc;
#pragma unroll
        for (int ai = 0; ai < 2; ++ai)
#pragma unroll
            for (int m = 0; m < 4; ++m) { const size_t off = (size_t)(ai * HALF + wr * 64 + m * 16 + fr) * ldc + col0;
#pragma unroll
                for (int bj = 0; bj < 2; ++bj)
#pragma unroll
                    for (int n = 0; n < 2; ++n) { const f32x4 bs = *(const f32x4*)(bb + off + bj * HALF + n * 16); *(f32x4*)(ob + off + bj * HALF + n * 16) = bs + acc[ai][bj][m][n] * alpha; }
                if (m & 1) asm volatile("" ::: "memory"); }
    }
};
struct EpiQKV {
    static constexpr bool PERM = true, AFTER_DRAIN = false;
    bf16_t* O; int ldc; const float* rope;
    __device__ __forceinline__ void operator()(f32x4 (&acc)[2][2][4][2], const Unit& u, int wr, int wc, int fr, int fq) const {
        const int row0 = u.pm * BM + wr * 64 + fr, col0 = u.pn * BM + wc * 32 + 8 * fq;
        if (u.pn < 16 && wc == 0) {
            const float sgn = (fq < 2) ? -1.f : 1.f;
#pragma unroll
            for (int ai = 0; ai < 2; ++ai)
#pragma unroll
                for (int m = 0; m < 4; ++m) { const int row = row0 + ai * HALF + m * 16; const int pos = (row < 16384) ? (row & 8191) : (row & 4095);
                    const f32x4* tb = (const f32x4*)(rope + (size_t)pos * 32 + 16 * (fq & 1));
                    const f32x4 t0 = tb[0], t1 = tb[1], t2 = tb[2], t3 = tb[3];
                    const float cs[8] = {t0[0], t0[2], t1[0], t1[2], t2[0], t2[2], t3[0], t3[2]}, sn[8] = {t0[1], t0[3], t1[1], t1[3], t2[1], t2[3], t3[1], t3[3]};
#pragma unroll
                    for (int bj = 0; bj < 2; ++bj)
#pragma unroll
                        for (int n = 0; n < 2; ++n)
#pragma unroll
                            for (int i = 0; i < 4; ++i) { const float v = acc[ai][bj][m][n][i]; const float pv = __shfl_xor(v, 32); acc[ai][bj][m][n][i] = v * cs[4 * n + i] + sgn * pv * sn[4 * n + i]; } }
        }
#pragma unroll
        for (int ai = 0; ai < 2; ++ai)
#pragma unroll
            for (int m = 0; m < 4; ++m) { bf16_t* rowp = O + (size_t)(row0 + ai * HALF + m * 16) * ldc + col0;
#pragma unroll
                for (int bj = 0; bj < 2; ++bj) { const f32x4 v0 = acc[ai][bj][m][0], v1 = acc[ai][bj][m][1];
                    u32x4 w; w.x = cvt_pk_bf16(v0[0], v0[1]); w.y = cvt_pk_bf16(v0[2], v0[3]); w.z = cvt_pk_bf16(v1[0], v1[1]); w.w = cvt_pk_bf16(v1[2], v1[3]);
                    *(u32x4*)(rowp + bj * HALF) = w; } }
    }
};

template <class Epi, class Sched, bool ALIGN_EPI = false, bool SP2 = false>
__device__ __forceinline__ void gemm_phase(PG8_LAS unsigned char* lds, const Gemm g, const Sched& S, const Epi& E) {
    const int tid = threadIdx.x, wid = __builtin_amdgcn_readfirstlane(tid >> 6), lane = tid & 63, wr = wid >> 2, wc = wid & 3, fr = lane & 15, fq = lane >> 4;
    const int K = g.K, nt = K / BK;
    unsigned voffA[2], voffB[2];
#pragma unroll
    for (int i = 0; i < 2; ++i) { int R, C; stage_rc(tid * 16 + i * 8192, R, C); const int Rb = Epi::PERM ? ((R & ~31) + perm32(R & 31)) : R;
        voffA[i] = (unsigned)(R * K + C) * 2u; voffB[i] = (unsigned)(Rb * K + C) * 2u; }
    const size_t kstep = (size_t)(BK * 2);
    const size_t hstep = (size_t)HALF * K * 2;
    const size_t tstep = 2 * hstep;
    const unsigned ldsw = (unsigned)wid * 1024u;
    const int aoff = lds_byte(wr * 64 + fr, fq * 8), boff = lds_byte(wc * 32 + fr, fq * 8);
#define PG8_SA(b, h) (((b) * 2 + (h)) * HTB)
#define PG8_SB(b, h) ((4 + (b) * 2 + (h)) * HTB)
#define PG8_STAGE(bufoff, gbase, voff) do { _Pragma("unroll") for (int _i = 0; _i < 2; ++_i) \
        __builtin_amdgcn_global_load_lds((const unsigned*)((const char*)(gbase) + (voff)[_i]), (PG8_LAS unsigned*)(lds + (bufoff) + ldsw + _i * 8192), 16, 0, 0); } while (0)
#define PG8_LDA(dst, b, h) do { _Pragma("unroll") for (int m = 0; m < 4; ++m) _Pragma("unroll") for (int k = 0; k < 2; ++k) dst[m][k] = *(const PG8_LAS bf16x8*)(lds + PG8_SA(b, h) + aoff + m * 2048 + k * 1024); } while (0)
#define PG8_LDB(dst, b, h) do { _Pragma("unroll") for (int n = 0; n < 2; ++n) _Pragma("unroll") for (int k = 0; k < 2; ++k) dst[n][k] = *(const PG8_LAS bf16x8*)(lds + PG8_SB(b, h) + boff + n * 2048 + k * 1024); } while (0)
#define PG8_MMA(ai, bj, At, Bt) do { __builtin_amdgcn_s_setprio(1); _Pragma("unroll") for (int m = 0; m < 4; ++m) _Pragma("unroll") for (int n = 0; n < 2; ++n) _Pragma("unroll") for (int k = 0; k < 2; ++k) \
        acc[ai][bj][m][n] = __builtin_amdgcn_mfma_f32_16x16x32_bf16(Bt[n][k], At[m][k], acc[ai][bj][m][n], 0, 0, 0); __builtin_amdgcn_s_setprio(0); } while (0)
#define PG8_WAIT_V(n) asm volatile("s_waitcnt vmcnt(" #n ")" ::: "memory")
#define PG8_WAIT_L(n) asm volatile("s_waitcnt lgkmcnt(" #n ")" ::: "memory")
#define PG8_BAR __builtin_amdgcn_s_barrier()
#define PG8_SCHED __builtin_amdgcn_sched_barrier(0)
    Unit cur, nxt; int ui = 0;
    if (!S.next(0, cur)) return;
    f32x4 acc[2][2][4][2];
#pragma unroll
    for (int a = 0; a < 2; ++a)
#pragma unroll
        for (int b = 0; b < 2; ++b)
#pragma unroll
            for (int m = 0; m < 4; ++m)
#pragma unroll
                for (int n = 0; n < 2; ++n) acc[a][b][m][n] = (f32x4){0.f, 0.f, 0.f, 0.f};
    bf16x8 At[4][2], B0[2][2], B1[2][2];
    const char* cA = (const char*)g.A + (size_t)cur.pm * tstep; const char* cB = (const char*)g.Bt + (size_t)cur.pn * tstep;
    S.a_ready(cur);
    if constexpr (SP2) {
        PG8_STAGE(PG8_SB(0, 0), cB, voffB); PG8_STAGE(PG8_SB(0, 1), cB + hstep, voffB); PG8_STAGE(PG8_SA(0, 0), cA, voffA); PG8_STAGE(PG8_SA(0, 1), cA + hstep, voffA);
        if (wr == 1) PG8_BAR;
        PG8_WAIT_V(2); PG8_BAR;
        PG8_STAGE(PG8_SB(1, 0), cB + kstep, voffB); PG8_STAGE(PG8_SA(1, 0), cA + kstep, voffA); PG8_STAGE(PG8_SB(1, 1), cB + hstep + kstep, voffB);
        PG8_WAIT_V(6); PG8_BAR;
    } else {
        PG8_STAGE(PG8_SB(0, 0), cB, voffB); PG8_STAGE(PG8_SA(0, 0), cA, voffA); PG8_STAGE(PG8_SB(0, 1), cB + hstep, voffB); PG8_STAGE(PG8_SA(0, 1), cA + hstep, voffA);
        if (wr == 1) PG8_BAR;
        PG8_WAIT_V(4); PG8_BAR;
        PG8_STAGE(PG8_SB(1, 0), cB + kstep, voffB); PG8_STAGE(PG8_SA(1, 0), cA + kstep, voffA); PG8_STAGE(PG8_SB(1, 1), cB + hstep + kstep, voffB);
        PG8_WAIT_V(6); PG8_BAR;
    }
    for (;;) {
        const bool has_next = S.next(ui + 1, nxt);
        const char* nA = has_next ? (const char*)g.A + (size_t)nxt.pm * tstep : cA; const char* nB = has_next ? (const char*)g.Bt + (size_t)nxt.pn * tstep : cB;
        for (int t = 0; t < nt; t += 2) {
            const bool last = (t == nt - 2);
            const char* a1 = cA + (size_t)(t + 1) * kstep;
            const char* a2 = last ? nA : cA + (size_t)(t + 2) * kstep; const char* b2 = last ? nB : cB + (size_t)(t + 2) * kstep;
            const char* a3 = a2 + kstep; const char* b3 = b2 + kstep;
            if (last && has_next) S.a_ready(nxt);
            if constexpr (SP2) {
            PG8_LDB(B0, 0, 0); PG8_LDB(B1, 0, 1); PG8_SCHED; PG8_LDA(At, 0, 0); PG8_STAGE(PG8_SA(1, 1), a1 + hstep, voffA);
            PG8_WAIT_V(8); PG8_WAIT_L(0); PG8_BAR; PG8_MMA(0, 0, At, B0); PG8_MMA(0, 1, At, B1); PG8_BAR; PG8_SCHED;
            PG8_LDA(At, 0, 1); PG8_STAGE(PG8_SB(0, 0), b2, voffB); PG8_STAGE(PG8_SB(0, 1), b2 + hstep, voffB); PG8_STAGE(PG8_SA(0, 0), a2, voffA);
            PG8_WAIT_V(8); PG8_WAIT_L(0); PG8_BAR; PG8_MMA(1, 0, At, B0); PG8_MMA(1, 1, At, B1); PG8_BAR; PG8_SCHED;
            PG8_LDB(B0, 1, 0); PG8_LDB(B1, 1, 1); PG8_SCHED; PG8_LDA(At, 1, 0); PG8_STAGE(PG8_SA(0, 1), a2 + hstep, voffA);
            PG8_WAIT_V(8); PG8_WAIT_L(0); PG8_BAR; PG8_MMA(0, 0, At, B0); PG8_MMA(0, 1, At, B1); PG8_BAR; PG8_SCHED;
            PG8_LDA(At, 1, 1); PG8_STAGE(PG8_SB(1, 0), b3, voffB); PG8_STAGE(PG8_SB(1, 1), b3 + hstep, voffB); PG8_STAGE(PG8_SA(1, 0), a3, voffA);
            PG8_WAIT_V(8); PG8_WAIT_L(0); PG8_BAR; PG8_MMA(1, 0, At, B0); PG8_MMA(1, 1, At, B1); PG8_BAR; PG8_SCHED;
            } else {
            PG8_LDB(B0, 0, 0); PG8_SCHED; PG8_LDA(At, 0, 0); PG8_STAGE(PG8_SA(1, 1), a1 + hstep, voffA);
            PG8_WAIT_L(8); PG8_BAR; PG8_WAIT_L(0); PG8_MMA(0, 0, At, B0); PG8_BAR; PG8_SCHED;
            PG8_LDB(B1, 0, 1); PG8_STAGE(PG8_SB(0, 0), b2, voffB);
            PG8_BAR; PG8_WAIT_L(0); PG8_MMA(0, 1, At, B1); PG8_BAR;
            PG8_LDA(At, 0, 1); PG8_STAGE(PG8_SA(0, 0), a2, voffA);
            PG8_BAR; PG8_WAIT_L(0); PG8_MMA(1, 0, At, B0); PG8_BAR; PG8_SCHED;
            PG8_STAGE(PG8_SB(0, 1), b2 + hstep, voffB);
            PG8_WAIT_V(6); PG8_BAR; PG8_MMA(1, 1, At, B1); PG8_BAR;
            PG8_LDB(B0, 1, 0); PG8_SCHED; PG8_LDA(At, 1, 0); PG8_STAGE(PG8_SA(0, 1), a2 + hstep, voffA);
            PG8_WAIT_L(8); PG8_BAR; PG8_WAIT_L(0); PG8_MMA(0, 0, At, B0); PG8_BAR; PG8_SCHED;
            PG8_LDB(B1, 1, 1); PG8_STAGE(PG8_SB(1, 0), b3, voffB);
            PG8_BAR; PG8_WAIT_L(0); PG8_MMA(0, 1, At, B1); PG8_BAR;
            PG8_LDA(At, 1, 1); PG8_STAGE(PG8_SA(1, 0), a3, voffA);
            PG8_BAR; PG8_WAIT_L(0); PG8_MMA(1, 0, At, B0); PG8_BAR; PG8_SCHED;
            PG8_STAGE(PG8_SB(1, 1), b3 + hstep, voffB);
            PG8_WAIT_V(6); PG8_BAR; PG8_MMA(1, 1, At, B1); PG8_BAR;
            }
        }
        if constexpr (ALIGN_EPI) { if (wr == 0) PG8_BAR; }
        E(acc, cur, wr, wc, fr, fq); S.done(cur);
        if (!has_next) break;
#pragma unroll
        for (int a = 0; a < 2; ++a)
#pragma unroll
            for (int b = 0; b < 2; ++b)
#pragma unroll
                for (int m = 0; m < 4; ++m)
#pragma unroll
                    for (int n = 0; n < 2; ++n) acc[a][b][m][n] = (f32x4){0.f, 0.f, 0.f, 0.f};
        cur = nxt; cA = nA; cB = nB; ++ui;
        if constexpr (ALIGN_EPI) { if (wr == 1) PG8_BAR; }
    }
    PG8_WAIT_V(0);
    if constexpr (!ALIGN_EPI) { if (wr == 0) PG8_BAR; }
    PG8_BAR;
#undef PG8_SA
#undef PG8_SB
#undef PG8_STAGE
#undef PG8_LDA
#undef PG8_LDB
#undef PG8_MMA
#undef PG8_WAIT_V
#undef PG8_WAIT_L
#undef PG8_BAR
#undef PG8_SCHED
}
}

constexpr int NWAVES = 8;
constexpr int D = 4096, FF = 11008, NGU = 2 * FF, NQKV = 12288, HD = 128, WA = 2048;
constexpr int MP = 16384, MS = 8192, M = MP + MS;
constexpr float NORM_EPS = 1e-6f;
constexpr int N_PHASES = 14;
#ifndef MK_N_LAUNCHES
#define MK_N_LAUNCHES 1
#endif

constexpr size_t MiB = 1u << 20;
constexpr size_t WS_CTL = 0, CTL_ZERO_BYTES = 1 * MiB;
constexpr size_t WS_ROPE = 1 * MiB;
constexpr size_t WS_ML = 2 * MiB;
constexpr size_t WS_WGU1 = 8 * MiB;
constexpr size_t WS_WD1 = WS_WGU1 + 172 * MiB;
constexpr size_t WS_WGU2 = WS_WD1 + 86 * MiB;
constexpr size_t WS_WD2 = WS_WGU2 + 172 * MiB;
constexpr size_t WS_WQKV = WS_WD2 + 86 * MiB;
constexpr size_t WS_WO = WS_WQKV + 96 * MiB;
constexpr size_t WS_XN = WS_WO + 32 * MiB;
constexpr size_t WS_BIG = WS_XN + 192 * MiB;
constexpr size_t WS_END = WS_BIG + 576 * MiB;
static_assert((size_t)NGU * D * 2 == 172 * MiB && (size_t)D * FF * 2 == 86 * MiB && (size_t)M * D * 2 == 192 * MiB && (size_t)M * NQKV * 2 == 576 * MiB, "ws map");
constexpr int CW_TMO = 0, CW_CODE = 1, CW_BAR = 4096;

constexpr int RING_OFF = 0, RING_BYTES = 131072;
constexpr int LDSCTL_OFF = RING_BYTES, MISC_OFF = LDSCTL_OFF + 320;
constexpr int LDS_BYTES = 147456;

#define GAS __attribute__((address_space(1)))
#define LAS __attribute__((address_space(3)))
typedef unsigned short bf16;
typedef unsigned v4u __attribute__((ext_vector_type(4)));
typedef unsigned v2u __attribute__((ext_vector_type(2)));
typedef float f32x4 __attribute__((ext_vector_type(4)));
typedef float f32x16 __attribute__((ext_vector_type(16)));
typedef short bf16x8 __attribute__((ext_vector_type(8)));
typedef short s16x4 __attribute__((ext_vector_type(4)));
typedef GAS unsigned gu32;
#define RLX_AGENT __ATOMIC_RELAXED, __HIP_MEMORY_SCOPE_AGENT
__device__ __forceinline__ unsigned cvtpk(float lo, float hi) { unsigned r; asm volatile("v_cvt_pk_bf16_f32 %0, %1, %2" : "=v"(r) : "v"(lo), "v"(hi)); return r; }
__device__ __forceinline__ float bf_lo(unsigned w) { return __uint_as_float(w << 16); }
__device__ __forceinline__ float bf_hi(unsigned w) { return __uint_as_float(w & 0xffff0000u); }

#define XB_TMO      128
#define XB_XCNT(j)  (256  + 64 * (j))
#define XB_XSUB(j)  (1280 + 64 * (j))
#define XB_XGEN(j)  (2304 + 64 * (j))
#define XB_TOP      3328
#define XB_TOPGEN   3392
#define XCD_BAR_WORDS 3456
#define XB_SPIN_CAP (1u << 22)

__device__ __forceinline__ unsigned xb_ld(unsigned* p)              { return __hip_atomic_load(p, __ATOMIC_RELAXED, __HIP_MEMORY_SCOPE_AGENT); }
__device__ __forceinline__ unsigned xb_add(unsigned* p, unsigned v) { return __hip_atomic_fetch_add(p, v, __ATOMIC_RELAXED, __HIP_MEMORY_SCOPE_AGENT); }
__device__ __forceinline__ unsigned xb_xcc_id() { return (unsigned)__builtin_amdgcn_s_getreg((3 << 11) | 20) & 0xFu; }
#define XB_SPIN(cond, bar) do { unsigned _sp = 0; while (cond) { __builtin_amdgcn_s_sleep(1); \
    if ((++_sp & 255u) == 0u) { if (xb_ld(&(bar)[XB_TMO])) break; if (_sp > XB_SPIN_CAP) { atomicAdd(&(bar)[XB_TMO], 1u); break; } } } } while (0)

struct XcdBarrier { unsigned* bar; unsigned x; volatile LAS unsigned* st; };

__device__ __forceinline__ XcdBarrier xcd_barrier_post(unsigned* bar, volatile LAS unsigned* st) {
    XcdBarrier b; b.bar = bar; b.x = xb_xcc_id(); b.st = st;
    if (threadIdx.x == 0) (void)xb_add(&bar[XB_XCNT(b.x)], 1u);
    return b;
}
__device__ __forceinline__ void xcd_barrier_complete(unsigned* bar, unsigned x, unsigned& nloc, unsigned& nx) {
    const unsigned G = gridDim.x * gridDim.y * gridDim.z;
    unsigned sum, cnt, mine, sp = 0u;
    for (;;) {
        sum = 0u; cnt = 0u; mine = 0u;
#pragma unroll
        for (unsigned j = 0; j < 16; ++j) { const unsigned c = xb_ld(&bar[XB_XCNT(j)]); sum += c; cnt += (c > 0u) ? 1u : 0u; mine = (j == x) ? c : mine; }
        if (sum == G) break;
        __builtin_amdgcn_s_sleep(1);
        if ((++sp & 255u) == 0u) { if (xb_ld(&bar[XB_TMO])) break; if (sp > XB_SPIN_CAP) { atomicAdd(&bar[XB_TMO], 1u); break; } }
    }
    nloc = mine > 0u ? mine : 1u; nx = cnt > 0u ? cnt : 1u;
}
__device__ __forceinline__ void xcd_barrier(const XcdBarrier& b) {
    asm volatile("s_waitcnt vmcnt(0)" ::: "memory");
    __syncthreads();
    if (threadIdx.x == 0) {
        unsigned* bar = b.bar;
        __builtin_amdgcn_s_waitcnt(0);
        unsigned nloc = b.st[0], nx = b.st[1];
        if (nloc == 0u) { xcd_barrier_complete(bar, b.x, nloc, nx); b.st[0] = nloc; b.st[1] = nx; }
        const unsigned old = xb_add(&bar[XB_XSUB(b.x)], 1u);
        const unsigned gen = old / nloc;
        if (old + 1u == (gen + 1u) * nloc) {
            __builtin_amdgcn_fence(__ATOMIC_RELEASE, "agent");
            asm volatile("s_waitcnt vmcnt(0)" ::: "memory");
            const unsigned og = xb_add(&bar[XB_TOP], 1u);
            const unsigned tg = og / nx;
            if (og + 1u == (tg + 1u) * nx) xb_add(&bar[XB_TOPGEN], 1u);
            else XB_SPIN(xb_ld(&bar[XB_TOPGEN]) == tg, bar);
            __builtin_amdgcn_fence(__ATOMIC_ACQUIRE, "agent");
            xb_add(&bar[XB_XGEN(b.x)], 1u);
            asm volatile("s_waitcnt vmcnt(0)" ::: "memory");
        } else {
            XB_SPIN(xb_ld(&bar[XB_XGEN(b.x)]) == gen, bar);
            __builtin_amdgcn_fence(__ATOMIC_ACQUIRE, "agent");
            asm volatile("s_waitcnt vmcnt(0)" ::: "memory");
        }
    }
    __syncthreads();
}

struct Frame {
    LAS unsigned char* lds;
    volatile LAS unsigned* MISC;
    gu32* ctl;
    int tid, lane, wave;
    int vcu, G;
};
__device__ __forceinline__ float wave_sum(float v) {
#pragma unroll
    for (int o = 1; o < 64; o <<= 1) v += __shfl_xor(v, o);
    return v;
}

__device__ __forceinline__ void tr_item(const float* __restrict__ W, int K, int N, bf16* __restrict__ WT, int mode, int item, int lane) {
    const int nblk = N / 64, kb = item / nblk, nb = item - kb * nblk;
    const int q = lane >> 4, c = lane & 15;
    const float* src = W + (size_t)(64 * kb + 16 * q) * N + 64 * nb + 4 * c;
    f32x4 v[16];
#pragma unroll
    for (int i = 0; i < 16; ++i) v[i] = __builtin_nontemporal_load((const f32x4*)(src + (size_t)i * N));
#pragma unroll
    for (int j = 0; j < 4; ++j) {
        const int n = 64 * nb + 4 * c + j;
        const int row = (mode == 0) ? n : (256 * (n >> 7) + (n & 127) + (mode == 2 ? 128 : 0));
        v4u w0, w1;
        w0.x = cvtpk(v[0][j], v[1][j]); w0.y = cvtpk(v[2][j], v[3][j]); w0.z = cvtpk(v[4][j], v[5][j]); w0.w = cvtpk(v[6][j], v[7][j]);
        w1.x = cvtpk(v[8][j], v[9][j]); w1.y = cvtpk(v[10][j], v[11][j]); w1.z = cvtpk(v[12][j], v[13][j]); w1.w = cvtpk(v[14][j], v[15][j]);
        bf16* dst = WT + (size_t)row * K + 64 * kb + 16 * q;
        *(v4u*)dst = w0; *(v4u*)(dst + 8) = w1;
    }
}
__device__ __forceinline__ void rms_row_to_bf16(const float* __restrict__ xrow, const float* __restrict__ g, bf16* __restrict__ orow, int lane) {
    const f32x4* xr = (const f32x4*)xrow + lane; const f32x4* gr = (const f32x4*)g + lane;
    f32x4 v[16]; float s = 0.f;
#pragma unroll
    for (int j = 0; j < 16; ++j) { v[j] = xr[64 * j]; s += (v[j].x * v[j].x + v[j].y * v[j].y) + (v[j].z * v[j].z + v[j].w * v[j].w); }
    const float r = 1.0f / sqrtf(wave_sum(s) * (1.f / D) + NORM_EPS);
    v2u* o8 = (v2u*)orow + lane;
#pragma unroll
    for (int j = 0; j < 16; ++j) { const f32x4 gg = gr[64 * j]; v2u w; w.x = cvtpk(v[j].x * r * gg.x, v[j].y * r * gg.y); w.y = cvtpk(v[j].z * r * gg.z, v[j].w * r * gg.w); o8[64 * j] = w; }
}

namespace att {
constexpr int QLD = NQKV;
constexpr int SHM = 16384;
constexpr int LDS_V = 0, LDS_K = 2 * SHM, LDS_TBL = 4 * SHM, TBL_PITCH = 128, TBL_BYTES = 15 * TBL_PITCH * 4;
constexpr float SCALE = 0.08838834764831845f, LOG2E = 1.4426950408889634f, C2 = SCALE * LOG2E;
#define KSWZ(row, colB) ((row) * 256 + ((colB) ^ (((row) & 7) << 4)))
__device__ __forceinline__ int v_st(int k, int c) { const int kk = (k & ~0xC) | ((k & 4) << 1) | ((k & 8) >> 1); return ((kk >> 3) * 4 + (c >> 5)) * 512 + ((kk & 7) * 32 + (c & 31)) * 2; }
__device__ __forceinline__ int v_rd_base(int lane) { return ((lane & 3) << 3) | (((lane >> 2) & 3) << 6) | (((lane >> 4) & 1) << 5) | (((lane >> 5) & 1) << 8); }

template <int MODE, int CFG>
__device__ __forceinline__ void unit(const bf16* __restrict__ qkv, bf16* __restrict__ O, float* __restrict__ ML, const float* __restrict__ relbias,
                                     LAS unsigned char* lds, int seqbase, int T, int h, int j) {
    const int tid = threadIdx.x, wid = __builtin_amdgcn_readfirstlane(tid >> 6), lane = tid & 63, r32 = lane & 31, hi = lane >> 5;
    const int sr = tid >> 4, sc = (tid & 15) * 8;
    constexpr int dil = (MODE == 0) ? (CFG == 0 ? 1 : (CFG == 1 ? 4 : 16)) : 1;
    constexpr int QOFF = (MODE == 0) ? 0 : 6144, KOFF = (MODE == 0) ? 2048 : 8192, VOFF = (MODE == 0) ? 4096 : 10240, OOFF = (MODE == 0) ? 0 : 2048;
    int tq, t_lo, t_hi, tokA, g = 0;
    int a_lo, a_hi;
    int qrow = 0, rs = 0;
    if constexpr (MODE == 0) {
        const int L = T / dil, nb = L / 256; g = j / nb; const int l0 = (j - g * nb) * 256;
        tq = (l0 + 32 * wid + r32) * dil + g;
        t_lo = (l0 == 0) ? 1 : 0; t_hi = (l0 + 256 == L) ? 5 : 6;
        tokA = (l0 - 64 + sr) * dil + g;
        a_lo = wid >> 1; a_hi = (wid >> 1) + 2;
    } else {
        const int rows = T / 64, R0 = 4 * j; qrow = R0 + (wid >> 1);
        tq = 64 * qrow + 32 * (wid & 1) + r32;
        const int rs0 = min(max(R0 - 4, 0), rows - 8), rs3 = min(max(R0 + 3 - 4, 0), rows - 8);
        rs = min(max(qrow - 4, 0), rows - 8);
        t_lo = rs0; t_hi = rs3 + 8;
        tokA = sr;
        a_lo = rs; a_hi = rs + 7;
    }
    constexpr int TSTEP = 64 * dil, RSTEP = 32 * dil;
    const bf16* kbase = qkv + (size_t)seqbase * QLD + KOFF + h * HD + sc;
    const bf16* vbase = qkv + (size_t)seqbase * QLD + VOFF + h * HD + sc;
    LAS unsigned char* Vl = lds + LDS_V; LAS unsigned char* Kl = lds + LDS_K;
    const int kws = KSWZ(sr, sc * 2), vst0 = v_st(sr, sc), vst1 = v_st(32 + sr, sc);
    bf16x8 qr[8];
    { const bf16* qp = qkv + (size_t)(seqbase + tq) * QLD + QOFF + h * HD + hi * 8;
#pragma unroll
      for (int d0 = 0; d0 < 8; ++d0) qr[d0] = *(const bf16x8*)(qp + d0 * 16); }
    if constexpr (MODE == 1) {
        LAS float* tbl = (LAS float*)(lds + LDS_TBL);
        for (int e = tid; e < 15 * TBL_PITCH; e += NWAVES * 64) { const int dr = e >> 7, x = e & 127; const int dc = min(max(x - 63, -15), 15) + 15;
            tbl[e] = relbias[(h * 15 + dr) * 31 + dc] * LOG2E; }
    }
    bf16x8 st_k0, st_k1, st_v0, st_v1;
#define ATT_LOAD(t) do { const size_t o0_ = (size_t)(tokA + (t) * TSTEP) * QLD, o1_ = o0_ + (size_t)RSTEP * QLD; \
        st_k0 = *(const bf16x8*)(kbase + o0_); st_k1 = *(const bf16x8*)(kbase + o1_); st_v0 = *(const bf16x8*)(vbase + o0_); st_v1 = *(const bf16x8*)(vbase + o1_); } while (0)
#define ATT_WRITE(b) do { *(LAS bf16x8*)(Kl + (b) * SHM + kws) = st_k0; *(LAS bf16x8*)(Kl + (b) * SHM + kws + 32 * 256) = st_k1; \
        *(LAS bf16x8*)(Vl + (b) * SHM + vst0) = st_v0; *(LAS bf16x8*)(Vl + (b) * SHM + vst1) = st_v1; } while (0)
    ATT_LOAD(t_lo); ATT_WRITE(0);
    __syncthreads();
    float m_run = -1e30f, l_run = 0.f; f32x16 o[4];
#pragma unroll
    for (int d0 = 0; d0 < 4; ++d0)
#pragma unroll
        for (int r = 0; r < 16; ++r) o[d0][r] = 0.f;
    const int kb_lane = KSWZ(r32, hi * 16);
    const int vrb = v_rd_base(lane);
    int buf = 0;
    for (int t = t_lo; t < t_hi; ++t, buf ^= 1) {
        if (t + 1 < t_hi) ATT_LOAD(t + 1);
        if (t >= a_lo && t <= a_hi) {
            f32x16 p0, p1;
#pragma unroll
            for (int r = 0; r < 16; ++r) { p0[r] = 0.f; p1[r] = 0.f; }
            { const LAS unsigned char* kt = Kl + buf * SHM;
#pragma unroll
              for (int d0 = 0; d0 < 8; ++d0) { const int off = KSWZ(r32, ((d0 & 3) * 16 + hi * 8) * 2) + (d0 >> 2) * 128;
                  const bf16x8 b0 = *(const LAS bf16x8*)(kt + off), b1 = *(const LAS bf16x8*)(kt + off + 32 * 256);
                  p0 = __builtin_amdgcn_mfma_f32_32x32x16_bf16(b0, qr[d0], p0, 0, 0, 0);
                  p1 = __builtin_amdgcn_mfma_f32_32x32x16_bf16(b1, qr[d0], p1, 0, 0, 0); } }
            const float NEG = -__builtin_inff();
            if constexpr (MODE == 0) {
                const int db = 64 * t - 32 * wid + 4 * hi - r32;
#pragma unroll
                for (int r = 0; r < 16; ++r) { const int c = (r & 3) + 8 * (r >> 2);
                    p0[r] = ((unsigned)(db + c) < 129u) ? p0[r] * C2 : NEG;
                    p1[r] = ((unsigned)(db + c + 32) < 129u) ? p1[r] * C2 : NEG; }
            } else {
                const int cq = 32 * (wid & 1) + r32, cs = min(max(cq - 8, 0), 48);
                const int dr = t - qrow + 7;
                const LAS float* tb = (const LAS float*)(lds + LDS_TBL) + dr * TBL_PITCH + 63 + 4 * hi - cq;
                const int mb = 4 * hi - cs;
#pragma unroll
                for (int r = 0; r < 16; ++r) { const int c = (r & 3) + 8 * (r >> 2);
                    const float b0 = tb[c], b1 = tb[c + 32];
                    p0[r] = ((unsigned)(mb + c) < 16u) ? (p0[r] * C2 + b0) : NEG;
                    p1[r] = ((unsigned)(mb + c + 32) < 16u) ? (p1[r] * C2 + b1) : NEG; }
            }
            float pmax = p0[0];
#pragma unroll
            for (int r = 1; r < 16; ++r) pmax = fmaxf(pmax, p0[r]);
#pragma unroll
            for (int r = 0; r < 16; ++r) pmax = fmaxf(pmax, p1[r]);
            { auto rr = __builtin_amdgcn_permlane32_swap(__float_as_uint(pmax), __float_as_uint(pmax), false, false);
              pmax = fmaxf(__uint_as_float(rr[0]), __uint_as_float(rr[1])); }
            const float mn = fmaxf(m_run, pmax);
            const float alpha = __builtin_amdgcn_exp2f(m_run - mn);
            m_run = mn;
            float ps = 0.f;
#pragma unroll
            for (int r = 0; r < 16; ++r) { p0[r] = __builtin_amdgcn_exp2f(p0[r] - mn); ps += p0[r]; }
#pragma unroll
            for (int r = 0; r < 16; ++r) { p1[r] = __builtin_amdgcn_exp2f(p1[r] - mn); ps += p1[r]; }
            l_run = l_run * alpha + ps;
            bf16x8 pa0, pa1, pa2, pa3;
#define PK4(P, B_, OUT) do { unsigned a0 = cvtpk(P[B_+0], P[B_+1]), a1 = cvtpk(P[B_+2], P[B_+3]); \
            unsigned b0 = cvtpk(P[B_+4], P[B_+5]), b1 = cvtpk(P[B_+6], P[B_+7]); \
            auto r0 = __builtin_amdgcn_permlane32_swap(a0, b0, false, false); auto r1 = __builtin_amdgcn_permlane32_swap(a1, b1, false, false); \
            v4u w = {r0[0], r1[0], r0[1], r1[1]}; OUT = __builtin_bit_cast(bf16x8, w); } while (0)
            PK4(p0, 0, pa0); PK4(p0, 8, pa1); PK4(p1, 0, pa2); PK4(p1, 8, pa3);
#undef PK4
            if (__any(alpha < 1.f)) {
#pragma unroll
                for (int d0 = 0; d0 < 4; ++d0)
#pragma unroll
                    for (int r = 0; r < 16; ++r) o[d0][r] *= alpha;
            }
            const int vb0 = (int)(uintptr_t)(Vl + buf * SHM) + vrb;
#define TRRD(dst, off) asm volatile("ds_read_b64_tr_b16 %0, %1 offset:%2" : "=&v"(dst) : "v"(vb0), "i"(off) : "memory")
#define PV_D0(d0) do { s16x4 l0, l1, l2, l3, h0, h1, h2, h3; constexpr int b_ = (d0) * 512; \
            TRRD(l0, b_); TRRD(h0, b_ + 2048); TRRD(l1, b_ + 4096); TRRD(h1, b_ + 6144); TRRD(l2, b_ + 8192); TRRD(h2, b_ + 10240); TRRD(l3, b_ + 12288); TRRD(h3, b_ + 14336); \
            asm volatile("s_waitcnt lgkmcnt(0)" ::: "memory"); __builtin_amdgcn_sched_barrier(0); \
            o[d0] = __builtin_amdgcn_mfma_f32_32x32x16_bf16((bf16x8){l0[0], l0[1], l0[2], l0[3], h0[0], h0[1], h0[2], h0[3]}, pa0, o[d0], 0, 0, 0); \
            o[d0] = __builtin_amdgcn_mfma_f32_32x32x16_bf16((bf16x8){l1[0], l1[1], l1[2], l1[3], h1[0], h1[1], h1[2], h1[3]}, pa1, o[d0], 0, 0, 0); \
            o[d0] = __builtin_amdgcn_mfma_f32_32x32x16_bf16((bf16x8){l2[0], l2[1], l2[2], l2[3], h2[0], h2[1], h2[2], h2[3]}, pa2, o[d0], 0, 0, 0); \
            o[d0] = __builtin_amdgcn_mfma_f32_32x32x16_bf16((bf16x8){l3[0], l3[1], l3[2], l3[3], h3[0], h3[1], h3[2], h3[3]}, pa3, o[d0], 0, 0, 0); } while (0)
            PV_D0(0); PV_D0(1); PV_D0(2); PV_D0(3);
#undef PV_D0
#undef TRRD
        }
        if (t + 1 < t_hi) ATT_WRITE(buf ^ 1);
        __syncthreads();
    }
#undef ATT_LOAD
#undef ATT_WRITE
    float l_tot;
    { auto rr = __builtin_amdgcn_permlane32_swap(__float_as_uint(l_run), __float_as_uint(l_run), false, false);
      l_tot = __uint_as_float(rr[0]) + __uint_as_float(rr[1]); }
    bf16* orow = O + (size_t)(seqbase + tq) * D + OOFF + h * HD + 4 * hi;
    float* mlp = ML + ((size_t)(seqbase + tq) * 16 + h) * 2;
    float wa = 0.f, wb;
    if constexpr (MODE == 0 && CFG > 0) {
        const float m_o = mlp[0], l_o = mlp[1];
        const float mx = fmaxf(m_o, m_run);
        const float a = l_o * __builtin_amdgcn_exp2f(m_o - mx), a2 = __builtin_amdgcn_exp2f(m_run - mx);
        const float Lt = a + a2 * l_tot, inv = 1.0f / Lt;
        wa = a * inv; wb = a2 * inv;
        if (CFG == 1 && hi == 0) { mlp[0] = mx; mlp[1] = Lt; }
    } else {
        wb = 1.0f / l_tot;
        if (MODE == 0 && hi == 0) { mlp[0] = m_run; mlp[1] = l_tot; }
    }
#pragma unroll
    for (int d0 = 0; d0 < 4; ++d0)
#pragma unroll
        for (int rq = 0; rq < 4; ++rq) { v2u* p = (v2u*)(orow + 32 * d0 + 8 * rq);
            float x0 = o[d0][4 * rq] * wb, x1 = o[d0][4 * rq + 1] * wb, x2 = o[d0][4 * rq + 2] * wb, x3 = o[d0][4 * rq + 3] * wb;
            if constexpr (MODE == 0 && CFG > 0) { const v2u old = *p; x0 += wa * bf_lo(old.x); x1 += wa * bf_hi(old.x); x2 += wa * bf_lo(old.y); x3 += wa * bf_hi(old.y); }
            v2u w; w.x = cvtpk(x0, x1); w.y = cvtpk(x2, x3); *p = w; }
}
#undef KSWZ
}

struct Args { const float* in[17]; float* out; unsigned char* ws; int ph_lo, ph_hi; };
static_assert(sizeof(Args) == 17 * 8 + 8 + 8 + 8, "Args has no padding");

template <int CFG>
__device__ __forceinline__ void attn_subphase(Frame& F, const bf16* QKV, bf16* XN, float* ML, const float* relbias) {
    const int x = blockIdx.x & 7, jl = blockIdx.x >> 3;
    for (int i = 0; i < 6; ++i) {
        const int u = x * 192 + jl + 32 * i; int s, h, j, T, sb;
        if (u < 1024) { s = u >> 9; h = (u >> 5) & 15; j = u & 31; T = 8192; sb = s * 8192; }
        else { const int v = u - 1024; s = v >> 8; h = (v >> 4) & 15; j = v & 15; T = 4096; sb = MP + s * 4096; }
        att::unit<0, CFG>(QKV, XN, ML, relbias, F.lds + RING_OFF, sb, T, h, j);
    }
    for (int i = 0; i < 2; ++i) {
        const int u = 512 * CFG + x * 64 + jl + 32 * i; int s, h, j, T, sb;
        if (u < 1024) { s = u >> 9; h = (u >> 5) & 15; j = u & 31; T = 8192; sb = s * 8192; }
        else { const int v = u - 1024; s = v >> 8; h = (v >> 4) & 15; j = v & 15; T = 4096; sb = MP + s * 4096; }
        att::unit<1, 0>(QKV, XN, ML, relbias, F.lds + RING_OFF, sb, T, h, j);
    }
}

__global__ void __launch_bounds__(NWAVES * 64, 2) mega_fwd(Args args) {
    extern __shared__ __attribute__((aligned(16))) unsigned char lds[];
    Frame F;
    F.lds = (LAS unsigned char*)lds;
    F.MISC = (volatile LAS unsigned*)(F.lds + MISC_OFF);
    F.tid = threadIdx.x; F.lane = F.tid & 63; F.wave = __builtin_amdgcn_readfirstlane(F.tid >> 6);
    F.G = gridDim.x; { const int bx = blockIdx.x; F.vcu = (F.G % 8 == 0) ? (bx % 8) * (F.G / 8) + bx / 8 : bx; }
    unsigned char* ws = args.ws;
    F.ctl = (gu32*)(ws + WS_CTL);
    for (int u = F.tid; u < (LDS_BYTES - LDSCTL_OFF) / 4; u += NWAVES * 64) ((LAS unsigned*)(F.lds + LDSCTL_OFF))[u] = 0u;
    __syncthreads();
    XcdBarrier bar; bar.bar = (unsigned*)(F.ctl + CW_BAR); bar.x = 0; bar.st = nullptr;
    if (MK_N_LAUNCHES == 1) bar = xcd_barrier_post((unsigned*)(F.ctl + CW_BAR), F.MISC + 8);
    const int lo = args.ph_lo, hi = args.ph_hi;
#define IN(k) (lo <= (k) && (k) < hi)
#define SEAM(k) do { if (IN(k) && IN((k) + 1)) xcd_barrier(bar); } while (0)

    const float* x_p = args.in[0]; const float* x_s = args.in[1];
    float* out = args.out;
    bf16* Wgu1 = (bf16*)(ws + WS_WGU1); bf16* Wd1 = (bf16*)(ws + WS_WD1); bf16* Wgu2 = (bf16*)(ws + WS_WGU2); bf16* Wd2 = (bf16*)(ws + WS_WD2);
    bf16* Wqkv = (bf16*)(ws + WS_WQKV); bf16* Wo = (bf16*)(ws + WS_WO);
    bf16* XN = (bf16*)(ws + WS_XN); bf16* BIG = (bf16*)(ws + WS_BIG);
    float* ROPE = (float*)(ws + WS_ROPE); float* ML = (float*)(ws + WS_ML);
    const int gw = F.vcu * NWAVES + F.wave, NGW = F.G * NWAVES;

    if (IN(0)) {
        constexpr int I_G = (D / 64) * (FF / 64), I_D = (FF / 64) * (D / 64), I_QKV = (D / 64) * (NQKV / 64), I_O = (D / 64) * (D / 64);
        constexpr int NITEMS = 6 * I_G + I_QKV + I_O;
        for (int it = gw; it < NITEMS; it += NGW) {
            int r = it;
            if (r < I_G) { tr_item(args.in[3], D, FF, Wgu1, 1, r, F.lane); continue; } r -= I_G;
            if (r < I_G) { tr_item(args.in[4], D, FF, Wgu1, 2, r, F.lane); continue; } r -= I_G;
            if (r < I_D) { tr_item(args.in[5], FF, D, Wd1, 0, r, F.lane); continue; } r -= I_D;
            if (r < I_QKV) { tr_item(args.in[7], D, NQKV, Wqkv, 0, r, F.lane); continue; } r -= I_QKV;
            if (r < I_O) { tr_item(args.in[11], D, D, Wo, 0, r, F.lane); continue; } r -= I_O;
            if (r < I_G) { tr_item(args.in[13], D, FF, Wgu2, 1, r, F.lane); continue; } r -= I_G;
            if (r < I_G) { tr_item(args.in[14], D, FF, Wgu2, 2, r, F.lane); continue; } r -= I_G;
            tr_item(args.in[15], FF, D, Wd2, 0, r, F.lane);
        }
        for (int e = blockIdx.x * (NWAVES * 64) + F.tid; e < 8192 * 16; e += F.G * NWAVES * 64) {
            const int pos = e >> 4, i = e & 15;
            const float inv = powf(500000.0f, -(float)(2 * i) / 32.0f);
            const float ang = (float)pos * inv;
            const double rev = (double)ang * 0.15915494309189535;
            const float fr = (float)(rev - rint(rev));
            ROPE[2 * e] = __builtin_amdgcn_cosf(fr); ROPE[2 * e + 1] = __builtin_amdgcn_sinf(fr);
        }
        for (int m = gw; m < M; m += NGW) rms_row_to_bf16(m < MP ? x_p + (size_t)m * D : x_s + (size_t)(m - MP) * D, args.in[2], XN + (size_t)m * D, F.lane);
    }
    SEAM(0);
    if (IN(1)) {
        pg8::Gemm g{XN, Wgu1, M, NGU, D}; pg8::StaticOrder S; S.init(M, NGU, F.G, (int)blockIdx.x);
        pg8::EpiSwiGLU E{BIG, FF};
        pg8::gemm_phase<pg8::EpiSwiGLU, pg8::StaticOrder, true, true>(F.lds + RING_OFF, g, S, E);
    }
    SEAM(1);
    if (IN(2)) {
        pg8::Gemm g{BIG, Wd1, M, D, FF}; pg8::StaticOrder S; S.init(M, D, F.G, (int)blockIdx.x);
        pg8::EpiRes E{x_p, x_s, MP, out, D, 0.5f};
        pg8::gemm_phase<pg8::EpiRes, pg8::StaticOrder, true, true>(F.lds + RING_OFF, g, S, E);
    }
    SEAM(2);
    if (IN(3)) { for (int m = gw; m < M; m += NGW) rms_row_to_bf16(out + (size_t)m * D, args.in[6], XN + (size_t)m * D, F.lane); }
    SEAM(3);
    if (IN(4)) {
        pg8::Gemm g{XN, Wqkv, M, NQKV, D}; pg8::StaticOrder S; S.init(M, NQKV, F.G, (int)blockIdx.x);
        pg8::EpiQKV E{BIG, NQKV, ROPE};
        pg8::gemm_phase<pg8::EpiQKV, pg8::StaticOrder, true, true>(F.lds + RING_OFF, g, S, E);
    }
    SEAM(4);
    if (IN(5)) attn_subphase<0>(F, BIG, XN, ML, args.in[8]);
    SEAM(5);
    if (IN(6)) attn_subphase<1>(F, BIG, XN, ML, args.in[8]);
    SEAM(6);
    if (IN(7)) attn_subphase<2>(F, BIG, XN, ML, args.in[8]);
    SEAM(7);
    if (IN(8)) {
        const float* ga = args.in[9]; const float* gb = args.in[10];
        for (int m = gw; m < M; m += NGW) {
            v4u* rp = (v4u*)(XN + (size_t)m * D) + F.lane; v4u v[8]; float sa = 0.f, sb = 0.f;
#pragma unroll
            for (int j = 0; j < 8; ++j) { v[j] = rp[64 * j]; const float q = (bf_lo(v[j].x) * bf_lo(v[j].x) + bf_hi(v[j].x) * bf_hi(v[j].x)) + (bf_lo(v[j].y) * bf_lo(v[j].y) + bf_hi(v[j].y) * bf_hi(v[j].y))
                    + (bf_lo(v[j].z) * bf_lo(v[j].z) + bf_hi(v[j].z) * bf_hi(v[j].z)) + (bf_lo(v[j].w) * bf_lo(v[j].w) + bf_hi(v[j].w) * bf_hi(v[j].w)); if (j < 4) sa += q; else sb += q; }
            const float ra = 1.0f / sqrtf(wave_sum(sa) * (1.f / WA) + NORM_EPS), rb = 1.0f / sqrtf(wave_sum(sb) * (1.f / WA) + NORM_EPS);
#pragma unroll
            for (int j = 0; j < 8; ++j) { const float r = (j < 4) ? ra : rb; const float* gp = ((j < 4) ? ga : gb) + 8 * F.lane + 512 * (j & 3);
                const f32x4 g0 = *(const f32x4*)gp, g1 = *(const f32x4*)(gp + 4); v4u w;
                w.x = cvtpk(bf_lo(v[j].x) * r * g0.x, bf_hi(v[j].x) * r * g0.y); w.y = cvtpk(bf_lo(v[j].y) * r * g0.z, bf_hi(v[j].y) * r * g0.w);
                w.z = cvtpk(bf_lo(v[j].z) * r * g1.x, bf_hi(v[j].z) * r * g1.y); w.w = cvtpk(bf_lo(v[j].w) * r * g1.z, bf_hi(v[j].w) * r * g1.w);
                rp[64 * j] = w; }
        }
    }
    SEAM(8);
    if (IN(9)) {
        pg8::Gemm g{XN, Wo, M, D, D}; pg8::StaticOrder S; S.init(M, D, F.G, (int)blockIdx.x);
        pg8::EpiRes E{out, out, M, out, D, 1.0f};
        pg8::gemm_phase<pg8::EpiRes, pg8::StaticOrder, true, true>(F.lds + RING_OFF, g, S, E);
    }
    SEAM(9);
    if (IN(10)) { for (int m = gw; m < M; m += NGW) rms_row_to_bf16(out + (size_t)m * D, args.in[12], XN + (size_t)m * D, F.lane); }
    SEAM(10);
    if (IN(11)) {
        pg8::Gemm g{XN, Wgu2, M, NGU, D}; pg8::StaticOrder S; S.init(M, NGU, F.G, (int)blockIdx.x);
        pg8::EpiSwiGLU E{BIG, FF};
        pg8::gemm_phase<pg8::EpiSwiGLU, pg8::StaticOrder, true, true>(F.lds + RING_OFF, g, S, E);
    }
    SEAM(11);
    if (IN(12)) {
        pg8::Gemm g{BIG, Wd2, M, D, FF}; pg8::StaticOrder S; S.init(M, D, F.G, (int)blockIdx.x);
        pg8::EpiRes E{out, out, M, out, D, 0.5f};
        pg8::gemm_phase<pg8::EpiRes, pg8::StaticOrder, true, true>(F.lds + RING_OFF, g, S, E);
    }
    SEAM(12);
    if (IN(13)) {
        const float* gfin = args.in[16];
        unsigned bad = (__hip_atomic_load(F.ctl + CW_BAR + XB_TMO, RLX_AGENT) != 0u);
        for (int m = gw; m < M; m += NGW) {
            f32x4* xr = (f32x4*)(out + (size_t)m * D) + F.lane; const f32x4* gr = (const f32x4*)gfin + F.lane;
            f32x4 v[16]; float s = 0.f;
#pragma unroll
            for (int j = 0; j < 16; ++j) { v[j] = xr[64 * j]; s += (v[j].x * v[j].x + v[j].y * v[j].y) + (v[j].z * v[j].z + v[j].w * v[j].w); }
            float r = 1.0f / sqrtf(wave_sum(s) * (1.f / D) + NORM_EPS);
            if (bad) r = __builtin_nanf("");
#pragma unroll
            for (int j = 0; j < 16; ++j) { const f32x4 gg = gr[64 * j]; xr[64 * j] = v[j] * r * gg; }
        }
    }
#undef IN
#undef SEAM
}

extern "C" void kernel_launch(void* const* d_in, const int* in_sizes, int n_in, void* d_out, int out_size, void* d_ws, size_t ws_size, hipStream_t stream) {
    static int grid = 0;
    if (grid == 0) {
        if (n_in != 17 || in_sizes[0] != MP * D || in_sizes[1] != MS * D || out_size != M * D || ws_size < WS_END) {
            fprintf(stderr, "kernel_launch: unexpected shapes (n_in %d, in0 %d, in1 %d, out %d, ws %zu < %zu); nothing launched\n", n_in, n_in > 0 ? in_sizes[0] : -1, n_in > 1 ? in_sizes[1] : -1, out_size, ws_size, (size_t)WS_END);
            grid = -1; return; }
        int dev = 0, cus = 0, per_cu = 0;
        if (hipGetDevice(&dev) != hipSuccess || hipDeviceGetAttribute(&cus, hipDeviceAttributeMultiprocessorCount, dev) != hipSuccess) { grid = -1; return; }
        if (hipFuncSetAttribute((const void*)mega_fwd, hipFuncAttributeMaxDynamicSharedMemorySize, LDS_BYTES) != hipSuccess) { fprintf(stderr, "kernel_launch: hipFuncSetAttribute failed\n"); grid = -1; return; }
        if (hipOccupancyMaxActiveBlocksPerMultiprocessor(&per_cu, (const void*)mega_fwd, NWAVES * 64, LDS_BYTES) != hipSuccess || per_cu < 1)
            fprintf(stderr, "kernel_launch: note: occupancy query reports %d workgroups per CU\n", per_cu);
        (void)hipGetLastError();
        grid = cus;
        if (grid != 256) fprintf(stderr, "kernel_launch: note: %d CUs\n", grid);
    }
    if (grid < 0) return;
    if (hipMemsetAsync((char*)d_ws + WS_CTL, 0, CTL_ZERO_BYTES, stream) != hipSuccess) { fprintf(stderr, "kernel_launch: memset failed\n"); return; }
    Args a{};
    for (int i = 0; i < 17; ++i) a.in[i] = (const float*)d_in[i];
    a.out = (float*)d_out; a.ws = (unsigned char*)d_ws;
#if MK_N_LAUNCHES == 1
    a.ph_lo = 0; a.ph_hi = N_PHASES;
    hipLaunchKernelGGL(mega_fwd, dim3(grid), dim3(NWAVES * 64), LDS_BYTES, stream, a);
#else
    for (int p = 0; p < N_PHASES; ++p) { a.ph_lo = p; a.ph_hi = p + 1; hipLaunchKernelGGL(mega_fwd, dim3(grid), dim3(NWAVES * 64), LDS_BYTES, stream, a); }
#endif
    const hipError_t le = hipPeekAtLastError();
    if (le != hipSuccess) fprintf(stderr, "kernel_launch: launch failed: %s\n", hipGetErrorName(le));
}
```

```cpp
#include <hip/hip_runtime.h>
#include <cstdio>
#include <cstdint>

namespace pg8 {
#define PG8_LAS __attribute__((address_space(3)))
typedef unsigned short bf16_t;
typedef short bf16x8 __attribute__((ext_vector_type(8)));
typedef float f32x4 __attribute__((ext_vector_type(4)));
typedef unsigned u32x4 __attribute__((ext_vector_type(4)));
constexpr int BM = 256, BK = 64, HALF = 128, HTB = HALF * BK * 2  , STAGE_BYTES = 8 * HTB, NXCD = 8, WGM = 8;

__host__ __device__ __forceinline__ int lds_byte(int r, int c) { const int st = (r >> 4) * 2 + (c >> 5), rr = r & 15, cc = c & 31, ob = rr * 64 + cc * 2; return st * 1024 + (ob ^ (((ob >> 9) & 1) << 5)); }
__host__ __device__ __forceinline__ void stage_rc(int b, int& R, int& C) { const int st = b / 1024, sb = b % 1024, swz = sb ^ (((sb >> 9) & 1) << 5); R = (st >> 1) * 16 + swz / 64; C = (st & 1) * 32 + (swz % 64) / 2; }
__host__ __device__ __forceinline__ int perm32(int rho) { const int n = rho >> 4, i = rho & 15; return 8 * (i >> 2) + 4 * n + (i & 3); }

struct Unit { int pm, pn; };
struct Gemm { const bf16_t* A; const bf16_t* Bt; int M, N, K; };

struct StaticOrder {
    int nM, nN, nwg, G, c;
    __host__ __device__ void init(int M, int N, int G_, int c_) { nM = M / BM; nN = N / BM; nwg = nM * nN; G = G_; c = c_; }
    __host__ __device__ bool next(int i, Unit& u) const {
        const long L = (long)i * G + c; if (L >= nwg) return false;
        int wgid = (int)L; { const int q = nwg / NXCD, r = nwg % NXCD, xcd = wgid % NXCD, off = wgid / NXCD; wgid = (xcd < r ? xcd * (q + 1) : r * (q + 1) + (xcd - r) * q) + off; }
        const int nig = WGM * nN, gid = wgid / nig, fm = gid * WGM, gsz = (nM - fm) < WGM ? (nM - fm) : WGM;
        u.pm = fm + ((wgid % nig) % gsz); u.pn = (wgid % nig) / gsz; return true;
    }
    __device__ __forceinline__ void a_ready(const Unit&) const {}
    __device__ __forceinline__ void done(const Unit&) const {}
};

__device__ __forceinline__ unsigned cvt_pk_bf16(float lo, float hi) { unsigned r; asm volatile("v_cvt_pk_bf16_f32 %0, %1, %2" : "=v"(r) : "v"(lo), "v"(hi)); return r; }

struct EpiSwiGLU {
    static constexpr bool PERM = true, AFTER_DRAIN = false;
    bf16_t* O; int ldc; const float* ss;
    __device__ __forceinline__ void operator()(const f32x4 (&acc)[2][2][4][2], const Unit& u, int wr, int wc, int fr, int fq) const {
        const int row0 = u.pm * BM + wr * 64 + fr, col0 = u.pn * HALF + wc * 32 + 8 * fq;
        float rs[2][4];
#pragma unroll
        for (int ai = 0; ai < 2; ++ai)
#pragma unroll
            for (int m = 0; m < 4; ++m) rs[ai][m] = ss[row0 + ai * HALF + m * 16];
#pragma unroll
        for (int ai = 0; ai < 2; ++ai)
#pragma unroll
            for (int m = 0; m < 4; ++m) { bf16_t* rowp = O + (size_t)(row0 + ai * HALF + m * 16) * ldc + col0;
                const float r = __builtin_amdgcn_rsqf(rs[ai][m] * (1.0f / 4096.0f) + 1e-6f);
                float hv[8];
#pragma unroll
                for (int n = 0; n < 2; ++n)
#pragma unroll
                    for (int i = 0; i < 4; ++i) { const float g = acc[ai][0][m][n][i] * r, up = acc[ai][1][m][n][i] * r;
                        const float e = __builtin_amdgcn_exp2f(g * -1.4426950408889634f); hv[4 * n + i] = g * __builtin_amdgcn_rcpf(1.0f + e) * up; }
                u32x4 w; w.x = cvt_pk_bf16(hv[0], hv[1]); w.y = cvt_pk_bf16(hv[2], hv[3]); w.z = cvt_pk_bf16(hv[4], hv[5]); w.w = cvt_pk_bf16(hv[6], hv[7]);
                *(u32x4*)rowp = w; }
    }
};
__device__ __forceinline__ float bflo(unsigned w) { return __uint_as_float(w << 16); }
__device__ __forceinline__ float bfhi(unsigned w) { return __uint_as_float(w & 0xffff0000u); }
template <bool FINAL> struct EpiResBf {
    static constexpr bool PERM = true, AFTER_DRAIN = false;
    bf16_t* R; float* out; float alpha; float* ssq;
    __device__ __forceinline__ void operator()(const f32x4 (&acc)[2][2][4][2], const Unit& u, int wr, int wc, int fr, int fq) const {
        const int row0 = u.pm * BM + wr * 64 + fr, col0 = u.pn * BM + wc * 32 + 8 * fq;
#pragma unroll
        for (int ai = 0; ai < 2; ++ai) {
            u32x4 old[4][2];
#pragma unroll
            for (int m = 0; m < 4; ++m)
#pragma unroll
                for (int bj = 0; bj < 2; ++bj) old[m][bj] = *(const u32x4*)(R + (size_t)(row0 + ai * HALF + m * 16) * 4096 + col0 + bj * HALF);
#pragma unroll
            for (int m = 0; m < 4; ++m) { const int row = row0 + ai * HALF + m * 16; float sq = 0.f;
#pragma unroll
                for (int bj = 0; bj < 2; ++bj) { const u32x4 o = old[m][bj]; const f32x4 a0 = acc[ai][bj][m][0], a1 = acc[ai][bj][m][1];
                    const float h0 = bflo(o.x) + alpha * a0[0], h1 = bfhi(o.x) + alpha * a0[1], h2 = bflo(o.y) + alpha * a0[2], h3 = bfhi(o.y) + alpha * a0[3];
                    const float h4 = bflo(o.z) + alpha * a1[0], h5 = bfhi(o.z) + alpha * a1[1], h6 = bflo(o.w) + alpha * a1[2], h7 = bfhi(o.w) + alpha * a1[3];
                    sq += (h0 * h0 + h1 * h1) + (h2 * h2 + h3 * h3) + (h4 * h4 + h5 * h5) + (h6 * h6 + h7 * h7);
                    if constexpr (FINAL) { float* op = out + (size_t)row * 4096 + col0 + bj * HALF; *(f32x4*)op = (f32x4){h0, h1, h2, h3}; *(f32x4*)(op + 4) = (f32x4){h4, h5, h6, h7}; }
                    else { u32x4 w; w.x = cvt_pk_bf16(h0, h1); w.y = cvt_pk_bf16(h2, h3); w.z = cvt_pk_bf16(h4, h5); w.w = cvt_pk_bf16(h6, h7);
                        *(u32x4*)(R + (size_t)row * 4096 + col0 + bj * HALF) = w; } }
                sq += __shfl_xor(sq, 16); sq += __shfl_xor(sq, 32);
                if (fq == 0) unsafeAtomicAdd(ssq + row, sq); }
            asm volatile("" ::: "memory");
        }
    }
};
struct EpiQKV {
    static constexpr bool PERM = true, AFTER_DRAIN = false;
    bf16_t* O; int ldc; const float* rope; const float* ss;
    __device__ __forceinline__ void operator()(f32x4 (&acc)[2][2][4][2], const Unit& u, int wr, int wc, int fr, int fq) const {
        const int row0 = u.pm * BM + wr * 64 + fr, col0 = u.pn * BM + wc * 32 + 8 * fq;
#pragma unroll
        for (int ai = 0; ai < 2; ++ai)
#pragma unroll
            for (int m = 0; m < 4; ++m) { const float r = __builtin_amdgcn_rsqf(ss[row0 + ai * HALF + m * 16] * (1.0f / 4096.0f) + 1e-6f);
#pragma unroll
                for (int bj = 0; bj < 2; ++bj)
#pragma unroll
                    for (int n = 0; n < 2; ++n) acc[ai][bj][m][n] *= r; }
        if (u.pn < 16 && wc == 0) {
            const float sgn = (fq < 2) ? -1.f : 1.f;
#pragma unroll
            for (int ai = 0; ai < 2; ++ai)
#pragma unroll
                for (int m = 0; m < 4; ++m) { const int row = row0 + ai * HALF + m * 16; const int pos = (row < 16384) ? (row & 8191) : (row & 4095);
                    const f32x4* tb = (const f32x4*)(rope + (size_t)pos * 32 + 16 * (fq & 1));
                    const f32x4 t0 = tb[0], t1 = tb[1], t2 = tb[2], t3 = tb[3];
                    const float cs[8] = {t0[0], t0[2], t1[0], t1[2], t2[0], t2[2], t3[0], t3[2]}, sn[8] = {t0[1], t0[3], t1[1], t1[3], t2[1], t2[3], t3[1], t3[3]};
#pragma unroll
                    for (int bj = 0; bj < 2; ++bj)
#pragma unroll
                        for (int n = 0; n < 2; ++n)
#pragma unroll
                            for (int i = 0; i < 4; ++i) { const float v = acc[ai][bj][m][n][i]; const float pv = __shfl_xor(v, 32); acc[ai][bj][m][n][i] = v * cs[4 * n + i] + sgn * pv * sn[4 * n + i]; } }
        }
#pragma unroll
        for (int ai = 0; ai < 2; ++ai)
#pragma unroll
            for (int m = 0; m < 4; ++m) { bf16_t* rowp = O + (size_t)(row0 + ai * HALF + m * 16) * ldc + col0;
#pragma unroll
                for (int bj = 0; bj < 2; ++bj) { const f32x4 v0 = acc[ai][bj][m][0], v1 = acc[ai][bj][m][1];
                    u32x4 w; w.x = cvt_pk_bf16(v0[0], v0[1]); w.y = cvt_pk_bf16(v0[2], v0[3]); w.z = cvt_pk_bf16(v1[0], v1[1]); w.w = cvt_pk_bf16(v1[2], v1[3]);
                    *(u32x4*)(rowp + bj * HALF) = w; } }
    }
};

template <class Epi, class Sched, bool ALIGN_EPI = false, bool SP2 = false>
__device__ __forceinline__ void gemm_phase(PG8_LAS unsigned char* lds, const Gemm g, const Sched& S, const Epi& E) {
    const int tid = threadIdx.x, wid = __builtin_amdgcn_readfirstlane(tid >> 6), lane = tid & 63, wr = wid >> 2, wc = wid & 3, fr = lane & 15, fq = lane >> 4;
    const int K = g.K, nt = K / BK;
    unsigned voffA[2], voffB[2];
#pragma unroll
    for (int i = 0; i < 2; ++i) { int R, C; stage_rc(tid * 16 + i * 8192, R, C); const int Rb = Epi::PERM ? ((R & ~31) + perm32(R & 31)) : R;
        voffA[i] = (unsigned)(R * K + C) * 2u; voffB[i] = (unsigned)(Rb * K + C) * 2u; }
    const size_t kstep = (size_t)(BK * 2);
    const size_t hstep = (size_t)HALF * K * 2;
    const size_t tstep = 2 * hstep;
    const unsigned ldsw = (unsigned)wid * 1024u;
    const int aoff = lds_byte(wr * 64 + fr, fq * 8), boff = lds_byte(wc * 32 + fr, fq * 8);
#define PG8_SA(b, h) (((b) * 2 + (h)) * HTB)
#define PG8_SB(b, h) ((4 + (b) * 2 + (h)) * HTB)
#define PG8_STAGE(bufoff, gbase, voff) do { _Pragma("unroll") for (int _i = 0; _i < 2; ++_i) \
        __builtin_amdgcn_global_load_lds((const unsigned*)((const char*)(gbase) + (voff)[_i]), (PG8_LAS unsigned*)(lds + (bufoff) + ldsw + _i * 8192), 16, 0, 0); } while (0)
#define PG8_LDA(dst, b, h) do { _Pragma("unroll") for (int m = 0; m < 4; ++m) _Pragma("unroll") for (int k = 0; k < 2; ++k) dst[m][k] = *(const PG8_LAS bf16x8*)(lds + PG8_SA(b, h) + aoff + m * 2048 + k * 1024); } while (0)
#define PG8_LDB(dst, b, h) do { _Pragma("unroll") for (int n = 0; n < 2; ++n) _Pragma("unroll") for (int k = 0; k < 2; ++k) dst[n][k] = *(const PG8_LAS bf16x8*)(lds + PG8_SB(b, h) + boff + n * 2048 + k * 1024); } while (0)
#define PG8_MMA(ai, bj, At, Bt) do { __builtin_amdgcn_s_setprio(1); _Pragma("unroll") for (int m = 0; m < 4; ++m) _Pragma("unroll") for (int n = 0; n < 2; ++n) _Pragma("unroll") for (int k = 0; k < 2; ++k) \
        acc[ai][bj][m][n] = __builtin_amdgcn_mfma_f32_16x16x32_bf16(Bt[n][k], At[m][k], acc[ai][bj][m][n], 0, 0, 0); __builtin_amdgcn_s_setprio(0); } while (0)
#define PG8_WAIT_V(n) asm volatile("s_waitcnt vmcnt(" #n ")" ::: "memory")
#define PG8_WAIT_L(n) asm volatile("s_waitcnt lgkmcnt(" #n ")" ::: "memory")
#define PG8_BAR __builtin_amdgcn_s_barrier()
#define PG8_SCHED __builtin_amdgcn_sched_barrier(0)
    Unit cur, nxt; int ui = 0;
    if (!S.next(0, cur)) return;
    f32x4 acc[2][2][4][2];
#pragma unroll
    for (int a = 0; a < 2; ++a)
#pragma unroll
        for (int b = 0; b < 2; ++b)
#pragma unroll
            for (int m = 0; m < 4; ++m)
#pragma unroll
                for (int n = 0; n < 2; ++n) acc[a][b][m][n] = (f32x4){0.f, 0.f, 0.f, 0.f};
    bf16x8 At[4][2], B0[2][2], B1[2][2];
    const char* cA = (const char*)g.A + (size_t)cur.pm * tstep; const char* cB = (const char*)g.Bt + (size_t)cur.pn * tstep;
    S.a_ready(cur);
    if constexpr (SP2) {
        PG8_STAGE(PG8_SB(0, 0), cB, voffB); PG8_STAGE(PG8_SB(0, 1), cB + hstep, voffB); PG8_STAGE(PG8_SA(0, 0), cA, voffA); PG8_STAGE(PG8_SA(0, 1), cA + hstep, voffA);
        if (wr == 1) PG8_BAR;
        PG8_WAIT_V(2); PG8_BAR;
        PG8_STAGE(PG8_SB(1, 0), cB + kstep, voffB); PG8_STAGE(PG8_SA(1, 0), cA + kstep, voffA); PG8_STAGE(PG8_SB(1, 1), cB + hstep + kstep, voffB);
        PG8_WAIT_V(6); PG8_BAR;
    } else {
        PG8_STAGE(PG8_SB(0, 0), cB, voffB); PG8_STAGE(PG8_SA(0, 0), cA, voffA); PG8_STAGE(PG8_SB(0, 1), cB + hstep, voffB); PG8_STAGE(PG8_SA(0, 1), cA + hstep, voffA);
        if (wr == 1) PG8_BAR;
        PG8_WAIT_V(4); PG8_BAR;
        PG8_STAGE(PG8_SB(1, 0), cB + kstep, voffB); PG8_STAGE(PG8_SA(1, 0), cA + kstep, voffA); PG8_STAGE(PG8_SB(1, 1), cB + hstep + kstep, voffB);
        PG8_WAIT_V(6); PG8_BAR;
    }
    for (;;) {
        const bool has_next = S.next(ui + 1, nxt);
        const char* nA = has_next ? (const char*)g.A + (size_t)nxt.pm * tstep : cA; const char* nB = has_next ? (const char*)g.Bt + (size_t)nxt.pn * tstep : cB;
        for (int t = 0; t < nt; t += 2) {
            const bool last = (t == nt - 2);
            const char* a1 = cA + (size_t)(t + 1) * kstep;
            const char* a2 = last ? nA : cA + (size_t)(t + 2) * kstep; const char* b2 = last ? nB : cB + (size_t)(t + 2) * kstep;
            const char* a3 = a2 + kstep; const char* b3 = b2 + kstep;
            if (last && has_next) S.a_ready(nxt);
            if constexpr (SP2) {
            PG8_LDB(B0, 0, 0); PG8_LDB(B1, 0, 1); PG8_SCHED; PG8_LDA(At, 0, 0); PG8_STAGE(PG8_SA(1, 1), a1 + hstep, voffA);
            PG8_WAIT_V(8); PG8_WAIT_L(0); PG8_BAR; PG8_MMA(0, 0, At, B0); PG8_MMA(0, 1, At, B1); PG8_BAR; PG8_SCHED;
            PG8_LDA(At, 0, 1); PG8_STAGE(PG8_SB(0, 0), b2, voffB); PG8_STAGE(PG8_SB(0, 1), b2 + hstep, voffB); PG8_STAGE(PG8_SA(0, 0), a2, voffA);
            PG8_WAIT_V(8); PG8_WAIT_L(0); PG8_BAR; PG8_MMA(1, 0, At, B0); PG8_MMA(1, 1, At, B1); PG8_BAR; PG8_SCHED;
            PG8_LDB(B0, 1, 0); PG8_LDB(B1, 1, 1); PG8_SCHED; PG8_LDA(At, 1, 0); PG8_STAGE(PG8_SA(0, 1), a2 + hstep, voffA);
            PG8_WAIT_V(8); PG8_WAIT_L(0); PG8_BAR; PG8_MMA(0, 0, At, B0); PG8_MMA(0, 1, At, B1); PG8_BAR; PG8_SCHED;
            PG8_LDA(At, 1, 1); PG8_STAGE(PG8_SB(1, 0), b3, voffB); PG8_STAGE(PG8_SB(1, 1), b3 + hstep, voffB); PG8_STAGE(PG8_SA(1, 0), a3, voffA);
            PG8_WAIT_V(8); PG8_WAIT_L(0); PG8_BAR; PG8_MMA(1, 0, At, B0); PG8_MMA(1, 1, At, B1); PG8_BAR; PG8_SCHED;
            } else {
            PG8_LDB(B0, 0, 0); PG8_SCHED; PG8_LDA(At, 0, 0); PG8_STAGE(PG8_SA(1, 1), a1 + hstep, voffA);
            PG8_WAIT_L(8); PG8_BAR; PG8_WAIT_L(0); PG8_MMA(0, 0, At, B0); PG8_BAR; PG8_SCHED;
            PG8_LDB(B1, 0, 1); PG8_STAGE(PG8_SB(0, 0), b2, voffB);
            PG8_BAR; PG8_WAIT_L(0); PG8_MMA(0, 1, At, B1); PG8_BAR;
            PG8_LDA(At, 0, 1); PG8_STAGE(PG8_SA(0, 0), a2, voffA);
            PG8_BAR; PG8_WAIT_L(0); PG8_MMA(1, 0, At, B0); PG8_BAR; PG8_SCHED;
            PG8_STAGE(PG8_SB(0, 1), b2 + hstep, voffB);
            PG8_WAIT_V(6); PG8_BAR; PG8_MMA(1, 1, At, B1); PG8_BAR;
            PG8_LDB(B0, 1, 0); PG8_SCHED; PG8_LDA(At, 1, 0); PG8_STAGE(PG8_SA(0, 1), a2 + hstep, voffA);
            PG8_WAIT_L(8); PG8_BAR; PG8_WAIT_L(0); PG8_MMA(0, 0, At, B0); PG8_BAR; PG8_SCHED;
            PG8_LDB(B1, 1, 1); PG8_STAGE(PG8_SB(1, 0), b3, voffB);
            PG8_BAR; PG8_WAIT_L(0); PG8_MMA(0, 1, At, B1); PG8_BAR;
            PG8_LDA(At, 1, 1); PG8_STAGE(PG8_SA(1, 0), a3, voffA);
            PG8_BAR; PG8_WAIT_L(0); PG8_MMA(1, 0, At, B0); PG8_BAR; PG8_SCHED;
            PG8_STAGE(PG8_SB(1, 1), b3 + hstep, voffB);
            PG8_WAIT_V(6); PG8_BAR; PG8_MMA(1, 1, At, B1); PG8_BAR;
            }
        }
        if constexpr (ALIGN_EPI) { if (wr == 0) PG8_BAR; }
        E(acc, cur, wr, wc, fr, fq); S.done(cur);
        if (!has_next) break;
#pragma unroll
        for (int a = 0; a < 2; ++a)
#pragma unroll
            for (int b = 0; b < 2; ++b)
#pragma unroll
                for (int m = 0; m < 4; ++m)
#pragma unroll
                    for (int n = 0; n < 2; ++n) acc[a][b][m][n] = (f32x4){0.f, 0.f, 0.f, 0.f};
        cur = nxt; cA = nA; cB = nB; ++ui;
        if constexpr (ALIGN_EPI) { if (wr == 1) PG8_BAR; }
    }
    PG8_WAIT_V(0);
    if constexpr (!ALIGN_EPI) { if (wr == 0) PG8_BAR; }
    PG8_BAR;
#undef PG8_SA
#undef PG8_SB
#undef PG8_STAGE
#undef PG8_LDA
#undef PG8_LDB
#undef PG8_MMA
#undef PG8_WAIT_V
#undef PG8_WAIT_L
#undef PG8_BAR
#undef PG8_SCHED
}
}

constexpr int NWAVES = 8;
constexpr int D = 4096, FF = 11008, NGU = 2 * FF, NQKV = 12288, HD = 128, WA = 2048;
constexpr int MP = 16384, MS = 8192, M = MP + MS;
constexpr float NORM_EPS = 1e-6f;
constexpr int N_PHASES = 12;
#ifndef MK_N_LAUNCHES
#define MK_N_LAUNCHES 1
#endif

constexpr size_t MiB = 1u << 20;
constexpr size_t WS_CTL = 0, CTL_ZERO_BYTES = 1 * MiB;
constexpr size_t WS_ROPE = 1 * MiB;
constexpr size_t WS_ML = 2 * MiB;
constexpr size_t WS_WGU1 = 8 * MiB;
constexpr size_t WS_WD1 = WS_WGU1 + 172 * MiB;
constexpr size_t WS_WGU2 = WS_WD1 + 86 * MiB;
constexpr size_t WS_WD2 = WS_WGU2 + 172 * MiB;
constexpr size_t WS_WQKV = WS_WD2 + 86 * MiB;
constexpr size_t WS_WO = WS_WQKV + 96 * MiB;
constexpr size_t WS_XN = WS_WO + 32 * MiB;
constexpr size_t WS_MG = WS_WGU1;
constexpr size_t WS_BIG = WS_XN + 192 * MiB;
constexpr size_t WS_END = WS_BIG + 576 * MiB;
static_assert((size_t)NGU * D * 2 == 172 * MiB && (size_t)D * FF * 2 == 86 * MiB && (size_t)M * D * 2 == 192 * MiB && (size_t)M * NQKV * 2 == 576 * MiB, "ws map");
constexpr int CW_TMO = 0, CW_CODE = 1, CW_BAR = 4096;
constexpr size_t WS_SS = 64 * 1024;
static_assert(WS_SS + 4 * (size_t)M * 4 <= CTL_ZERO_BYTES && (CW_BAR + 3456) * 4 <= WS_SS, "ctl map");

constexpr int RING_OFF = 0, RING_BYTES = 131072;
constexpr int LDSCTL_OFF = RING_BYTES, MISC_OFF = LDSCTL_OFF + 320;
constexpr int LDS_BYTES = 147456;

#define GAS __attribute__((address_space(1)))
#define LAS __attribute__((address_space(3)))
typedef unsigned short bf16;
typedef unsigned v4u __attribute__((ext_vector_type(4)));
typedef unsigned v2u __attribute__((ext_vector_type(2)));
typedef float f32x4 __attribute__((ext_vector_type(4)));
typedef float f32x16 __attribute__((ext_vector_type(16)));
typedef short bf16x8 __attribute__((ext_vector_type(8)));
typedef short s16x4 __attribute__((ext_vector_type(4)));
typedef GAS unsigned gu32;
#define RLX_AGENT __ATOMIC_RELAXED, __HIP_MEMORY_SCOPE_AGENT
__device__ __forceinline__ unsigned cvtpk(float lo, float hi) { unsigned r; asm volatile("v_cvt_pk_bf16_f32 %0, %1, %2" : "=v"(r) : "v"(lo), "v"(hi)); return r; }
__device__ __forceinline__ float bf_lo(unsigned w) { return __uint_as_float(w << 16); }
__device__ __forceinline__ float bf_hi(unsigned w) { return __uint_as_float(w & 0xffff0000u); }

#define XB_TMO      128
#define XB_XCNT(j)  (256  + 64 * (j))
#define XB_XSUB(j)  (1280 + 64 * (j))
#define XB_XGEN(j)  (2304 + 64 * (j))
#define XB_TOP      3328
#define XB_TOPGEN   3392
#define XCD_BAR_WORDS 3456
#define XB_SPIN_CAP (1u << 22)

__device__ __forceinline__ unsigned xb_ld(unsigned* p)              { return __hip_atomic_load(p, __ATOMIC_RELAXED, __HIP_MEMORY_SCOPE_AGENT); }
__device__ __forceinline__ unsigned xb_add(unsigned* p, unsigned v) { return __hip_atomic_fetch_add(p, v, __ATOMIC_RELAXED, __HIP_MEMORY_SCOPE_AGENT); }
__device__ __forceinline__ unsigned xb_xcc_id() { return (unsigned)__builtin_amdgcn_s_getreg((3 << 11) | 20) & 0xFu; }
#define XB_SPIN(cond, bar) do { unsigned _sp = 0; while (cond) { __builtin_amdgcn_s_sleep(1); \
    if ((++_sp & 255u) == 0u) { if (xb_ld(&(bar)[XB_TMO])) break; if (_sp > XB_SPIN_CAP) { atomicAdd(&(bar)[XB_TMO], 1u); break; } } } } while (0)

struct XcdBarrier { unsigned* bar; unsigned x; volatile LAS unsigned* st; };

__device__ __forceinline__ XcdBarrier xcd_barrier_post(unsigned* bar, volatile LAS unsigned* st) {
    XcdBarrier b; b.bar = bar; b.x = xb_xcc_id(); b.st = st;
    if (threadIdx.x == 0) (void)xb_add(&bar[XB_XCNT(b.x)], 1u);
    return b;
}
__device__ __forceinline__ void xcd_barrier_complete(unsigned* bar, unsigned x, unsigned& nloc, unsigned& nx) {
    const unsigned G = gridDim.x * gridDim.y * gridDim.z;
    unsigned sum, cnt, mine, sp = 0u;
    for (;;) {
        sum = 0u; cnt = 0u; mine = 0u;
#pragma unroll
        for (unsigned j = 0; j < 16; ++j) { const unsigned c = xb_ld(&bar[XB_XCNT(j)]); sum += c; cnt += (c > 0u) ? 1u : 0u; mine = (j == x) ? c : mine; }
        if (sum == G) break;
        __builtin_amdgcn_s_sleep(1);
        if ((++sp & 255u) == 0u) { if (xb_ld(&bar[XB_TMO])) break; if (sp > XB_SPIN_CAP) { atomicAdd(&bar[XB_TMO], 1u); break; } }
    }
    nloc = mine > 0u ? mine : 1u; nx = cnt > 0u ? cnt : 1u;
}
__device__ __forceinline__ void xcd_barrier(const XcdBarrier& b) {
    asm volatile("s_waitcnt vmcnt(0)" ::: "memory");
    __syncthreads();
    if (threadIdx.x == 0) {
        unsigned* bar = b.bar;
        __builtin_amdgcn_s_waitcnt(0);
        unsigned nloc = b.st[0], nx = b.st[1];
        if (nloc == 0u) { xcd_barrier_complete(bar, b.x, nloc, nx); b.st[0] = nloc; b.st[1] = nx; }
        const unsigned old = xb_add(&bar[XB_XSUB(b.x)], 1u);
        const unsigned gen = old / nloc;
        if (old + 1u == (gen + 1u) * nloc) {
            __builtin_amdgcn_fence(__ATOMIC_RELEASE, "agent");
            asm volatile("s_waitcnt vmcnt(0)" ::: "memory");
            const unsigned og = xb_add(&bar[XB_TOP], 1u);
            const unsigned tg = og / nx;
            if (og + 1u == (tg + 1u) * nx) xb_add(&bar[XB_TOPGEN], 1u);
            else XB_SPIN(xb_ld(&bar[XB_TOPGEN]) == tg, bar);
            __builtin_amdgcn_fence(__ATOMIC_ACQUIRE, "agent");
            xb_add(&bar[XB_XGEN(b.x)], 1u);
            asm volatile("s_waitcnt vmcnt(0)" ::: "memory");
        } else {
            XB_SPIN(xb_ld(&bar[XB_XGEN(b.x)]) == gen, bar);
            __builtin_amdgcn_fence(__ATOMIC_ACQUIRE, "agent");
            asm volatile("s_waitcnt vmcnt(0)" ::: "memory");
        }
    }
    __syncthreads();
}

struct Frame {
    LAS unsigned char* lds;
    volatile LAS unsigned* MISC;
    gu32* ctl;
    int tid, lane, wave;
    int vcu, G;
};
__device__ __forceinline__ float wave_sum(float v) {
#pragma unroll
    for (int o = 1; o < 64; o <<= 1) v += __shfl_xor(v, o);
    return v;
}

__device__ __forceinline__ void tr_item(const float* __restrict__ W, int K, int N, bf16* __restrict__ WT, int mode, const float* __restrict__ gk, int item, int lane) {
    const int nblk = N / 64, kb = item / nblk, nb = item - kb * nblk;
    const int q = lane >> 4, c = lane & 15;
    const float* src = W + (size_t)(64 * kb + 16 * q) * N + 64 * nb + 4 * c;
    f32x4 v[16];
#pragma unroll
    for (int i = 0; i < 16; ++i) v[i] = __builtin_nontemporal_load((const f32x4*)(src + (size_t)i * N));
    if (gk) { const f32x4* gp = (const f32x4*)(gk + 64 * kb + 16 * q);
#pragma unroll
        for (int i4 = 0; i4 < 4; ++i4) { const f32x4 gg = gp[i4]; v[4 * i4] *= gg.x; v[4 * i4 + 1] *= gg.y; v[4 * i4 + 2] *= gg.z; v[4 * i4 + 3] *= gg.w; } }
#pragma unroll
    for (int j = 0; j < 4; ++j) {
        const int n = 64 * nb + 4 * c + j;
        const int row = (mode == 0) ? n : (256 * (n >> 7) + (n & 127) + (mode == 2 ? 128 : 0));
        v4u w0, w1;
        w0.x = cvtpk(v[0][j], v[1][j]); w0.y = cvtpk(v[2][j], v[3][j]); w0.z = cvtpk(v[4][j], v[5][j]); w0.w = cvtpk(v[6][j], v[7][j]);
        w1.x = cvtpk(v[8][j], v[9][j]); w1.y = cvtpk(v[10][j], v[11][j]); w1.z = cvtpk(v[12][j], v[13][j]); w1.w = cvtpk(v[14][j], v[15][j]);
        bf16* dst = WT + (size_t)row * K + 64 * kb + 16 * q;
        *(v4u*)dst = w0; *(v4u*)(dst + 8) = w1;
    }
}
__device__ __forceinline__ void cvt_row_to_bf16(const float* __restrict__ xrow, bf16* __restrict__ orow, float* __restrict__ ssq, int lane) {
    const f32x4* xr = (const f32x4*)xrow + lane;
    f32x4 v[16]; float s = 0.f;
#pragma unroll
    for (int j = 0; j < 16; ++j) { v[j] = __builtin_nontemporal_load(xr + 64 * j); s += (v[j].x * v[j].x + v[j].y * v[j].y) + (v[j].z * v[j].z + v[j].w * v[j].w); }
    s = wave_sum(s);
    v2u* o8 = (v2u*)orow + lane;
#pragma unroll
    for (int j = 0; j < 16; ++j) { v2u w; w.x = cvtpk(v[j].x, v[j].y); w.y = cvtpk(v[j].z, v[j].w); o8[64 * j] = w; }
    if (lane == 0) *ssq = s;
}

namespace att {
constexpr int QLD = NQKV;
constexpr int SHM = 16384;
constexpr int LDS_V = 0, LDS_K = 2 * SHM, LDS_TBL = 4 * SHM, TBL_PITCH = 128, TBL_BYTES = 15 * TBL_PITCH * 4;
constexpr float SCALE = 0.08838834764831845f, LOG2E = 1.4426950408889634f, C2 = SCALE * LOG2E;
#define KSWZ(row, colB) ((row) * 256 + ((colB) ^ (((row) & 7) << 4)))
__device__ __forceinline__ int v_st(int k, int c) { const int kk = (k & ~0xC) | ((k & 4) << 1) | ((k & 8) >> 1); return ((kk >> 3) * 4 + (c >> 5)) * 512 + ((kk & 7) * 32 + (c & 31)) * 2; }
__device__ __forceinline__ int v_rd_base(int lane) { return ((lane & 3) << 3) | (((lane >> 2) & 3) << 6) | (((lane >> 4) & 1) << 5) | (((lane >> 5) & 1) << 8); }

template <int MODE, int CFG>
__device__ __forceinline__ void unit(const bf16* __restrict__ qkv, bf16* __restrict__ O, float* __restrict__ ML, const float* __restrict__ relbias,
                                     LAS unsigned char* lds, int seqbase, int T, int h, int j) {
    const int tid = threadIdx.x, wid = __builtin_amdgcn_readfirstlane(tid >> 6), lane = tid & 63, r32 = lane & 31, hi = lane >> 5;
    const int sr = tid >> 4, sc = (tid & 15) * 8;
    constexpr int dil = (MODE == 0) ? (CFG == 0 ? 1 : (CFG == 1 ? 4 : 16)) : 1;
    constexpr int QOFF = (MODE == 0) ? 0 : 6144, KOFF = (MODE == 0) ? 2048 : 8192, VOFF = (MODE == 0) ? 4096 : 10240, OOFF = (MODE == 0) ? 0 : 2048;
    int tq, t_lo, t_hi, tokA, g = 0;
    int a_lo, a_hi;
    int qrow = 0, rs = 0;
    if constexpr (MODE == 0) {
        const int L = T / dil, nb = L / 256; g = j / nb; const int l0 = (j - g * nb) * 256;
        tq = (l0 + 32 * wid + r32) * dil + g;
        t_lo = (l0 == 0) ? 1 : 0; t_hi = (l0 + 256 == L) ? 5 : 6;
        tokA = (l0 - 64 + sr) * dil + g;
        a_lo = wid >> 1; a_hi = (wid >> 1) + 2;
    } else {
        const int rows = T / 64, R0 = 4 * j; qrow = R0 + (wid >> 1);
        tq = 64 * qrow + 32 * (wid & 1) + r32;
        const int rs0 = min(max(R0 - 4, 0), rows - 8), rs3 = min(max(R0 + 3 - 4, 0), rows - 8);
        rs = min(max(qrow - 4, 0), rows - 8);
        t_lo = rs0; t_hi = rs3 + 8;
        tokA = sr;
        a_lo = rs; a_hi = rs + 7;
    }
    constexpr int TSTEP = 64 * dil, RSTEP = 32 * dil;
    const bf16* kbase = qkv + (size_t)seqbase * QLD + KOFF + h * HD + sc;
    const bf16* vbase = qkv + (size_t)seqbase * QLD + VOFF + h * HD + sc;
    LAS unsigned char* Vl = lds + LDS_V; LAS unsigned char* Kl = lds + LDS_K;
    const int kws = KSWZ(sr, sc * 2), vst0 = v_st(sr, sc), vst1 = v_st(32 + sr, sc);
    bf16x8 qr[8];
    { const bf16* qp = qkv + (size_t)(seqbase + tq) * QLD + QOFF + h * HD + hi * 8;
#pragma unroll
      for (int d0 = 0; d0 < 8; ++d0) qr[d0] = *(const bf16x8*)(qp + d0 * 16); }
    if constexpr (MODE == 1) {
        LAS float* tbl = (LAS float*)(lds + LDS_TBL);
        for (int e = tid; e < 15 * TBL_PITCH; e += NWAVES * 64) { const int dr = e >> 7, x = e & 127; const int dc = min(max(x - 63, -15), 15) + 15;
            tbl[e] = relbias[(h * 15 + dr) * 31 + dc] * LOG2E; }
    }
    bf16x8 st_k0, st_k1, st_v0, st_v1;
#define ATT_LOAD(t) do { const size_t o0_ = (size_t)(tokA + (t) * TSTEP) * QLD, o1_ = o0_ + (size_t)RSTEP * QLD; \
        st_k0 = *(const bf16x8*)(kbase + o0_); st_k1 = *(const bf16x8*)(kbase + o1_); st_v0 = *(const bf16x8*)(vbase + o0_); st_v1 = *(const bf16x8*)(vbase + o1_); } while (0)
#define ATT_WRITE(b) do { *(LAS bf16x8*)(Kl + (b) * SHM + kws) = st_k0; *(LAS bf16x8*)(Kl + (b) * SHM + kws + 32 * 256) = st_k1; \
        *(LAS bf16x8*)(Vl + (b) * SHM + vst0) = st_v0; *(LAS bf16x8*)(Vl + (b) * SHM + vst1) = st_v1; } while (0)
    ATT_LOAD(t_lo); ATT_WRITE(0);
    __syncthreads();
    float m_run = -1e30f, l_run = 0.f; f32x16 o[4];
#pragma unroll
    for (int d0 = 0; d0 < 4; ++d0)
#pragma unroll
        for (int r = 0; r < 16; ++r) o[d0][r] = 0.f;
    const int kb_lane = KSWZ(r32, hi * 16);
    const int vrb = v_rd_base(lane);
    int buf = 0;
    for (int t = t_lo; t < t_hi; ++t, buf ^= 1) {
        if (t + 1 < t_hi) ATT_LOAD(t + 1);
        if (t >= a_lo && t <= a_hi) {
            f32x16 p0, p1;
#pragma unroll
            for (int r = 0; r < 16; ++r) { p0[r] = 0.f; p1[r] = 0.f; }
            { const LAS unsigned char* kt = Kl + buf * SHM;
#pragma unroll
              for (int d0 = 0; d0 < 8; ++d0) { const int off = KSWZ(r32, ((d0 & 3) * 16 + hi * 8) * 2) + (d0 >> 2) * 128;
                  const bf16x8 b0 = *(const LAS bf16x8*)(kt + off), b1 = *(const LAS bf16x8*)(kt + off + 32 * 256);
                  p0 = __builtin_amdgcn_mfma_f32_32x32x16_bf16(b0, qr[d0], p0, 0, 0, 0);
                  p1 = __builtin_amdgcn_mfma_f32_32x32x16_bf16(b1, qr[d0], p1, 0, 0, 0); } }
            const float NEG = -__builtin_inff();
            if constexpr (MODE == 0) {
                const int db = 64 * t - 32 * wid + 4 * hi - r32;
#pragma unroll
                for (int r = 0; r < 16; ++r) { const int c = (r & 3) + 8 * (r >> 2);
                    p0[r] = ((unsigned)(db + c) < 129u) ? p0[r] * C2 : NEG;
                    p1[r] = ((unsigned)(db + c + 32) < 129u) ? p1[r] * C2 : NEG; }
            } else {
                const int cq = 32 * (wid & 1) + r32, cs = min(max(cq - 8, 0), 48);
                const int dr = t - qrow + 7;
                const LAS float* tb = (const LAS float*)(lds + LDS_TBL) + dr * TBL_PITCH + 63 + 4 * hi - cq;
                const int mb = 4 * hi - cs;
#pragma unroll
                for (int r = 0; r < 16; ++r) { const int c = (r & 3) + 8 * (r >> 2);
                    const float b0 = tb[c], b1 = tb[c + 32];
                    p0[r] = ((unsigned)(mb + c) < 16u) ? (p0[r] * C2 + b0) : NEG;
                    p1[r] = ((unsigned)(mb + c + 32) < 16u) ? (p1[r] * C2 + b1) : NEG; }
            }
            float pmax = p0[0];
#pragma unroll
            for (int r = 1; r < 16; ++r) pmax = fmaxf(pmax, p0[r]);
#pragma unroll
            for (int r = 0; r < 16; ++r) pmax = fmaxf(pmax, p1[r]);
            { auto rr = __builtin_amdgcn_permlane32_swap(__float_as_uint(pmax), __float_as_uint(pmax), false, false);
              pmax = fmaxf(__uint_as_float(rr[0]), __uint_as_float(rr[1])); }
            const float mn = fmaxf(m_run, pmax);
            const float alpha = __builtin_amdgcn_exp2f(m_run - mn);
            m_run = mn;
            float ps = 0.f;
#pragma unroll
            for (int r = 0; r < 16; ++r) { p0[r] = __builtin_amdgcn_exp2f(p0[r] - mn); ps += p0[r]; }
#pragma unroll
            for (int r = 0; r < 16; ++r) { p1[r] = __builtin_amdgcn_exp2f(p1[r] - mn); ps += p1[r]; }
            l_run = l_run * alpha + ps;
            bf16x8 pa0, pa1, pa2, pa3;
#define PK4(P, B_, OUT) do { unsigned a0 = cvtpk(P[B_+0], P[B_+1]), a1 = cvtpk(P[B_+2], P[B_+3]); \
            unsigned b0 = cvtpk(P[B_+4], P[B_+5]), b1 = cvtpk(P[B_+6], P[B_+7]); \
            auto r0 = __builtin_amdgcn_permlane32_swap(a0, b0, false, false); auto r1 = __builtin_amdgcn_permlane32_swap(a1, b1, false, false); \
            v4u w = {r0[0], r1[0], r0[1], r1[1]}; OUT = __builtin_bit_cast(bf16x8, w); } while (0)
            PK4(p0, 0, pa0); PK4(p0, 8, pa1); PK4(p1, 0, pa2); PK4(p1, 8, pa3);
#undef PK4
            if (__any(alpha < 1.f)) {
#pragma unroll
                for (int d0 = 0; d0 < 4; ++d0)
#pragma unroll
                    for (int r = 0; r < 16; ++r) o[d0][r] *= alpha;
            }
            const int vb0 = (int)(uintptr_t)(Vl + buf * SHM) + vrb;
#define TRRD(dst, off) asm volatile("ds_read_b64_tr_b16 %0, %1 offset:%2" : "=&v"(dst) : "v"(vb0), "i"(off) : "memory")
#define PV_D0(d0) do { s16x4 l0, l1, l2, l3, h0, h1, h2, h3; constexpr int b_ = (d0) * 512; \
            TRRD(l0, b_); TRRD(h0, b_ + 2048); TRRD(l1, b_ + 4096); TRRD(h1, b_ + 6144); TRRD(l2, b_ + 8192); TRRD(h2, b_ + 10240); TRRD(l3, b_ + 12288); TRRD(h3, b_ + 14336); \
            asm volatile("s_waitcnt lgkmcnt(0)" ::: "memory"); __builtin_amdgcn_sched_barrier(0); \
            o[d0] = __builtin_amdgcn_mfma_f32_32x32x16_bf16((bf16x8){l0[0], l0[1], l0[2], l0[3], h0[0], h0[1], h0[2], h0[3]}, pa0, o[d0], 0, 0, 0); \
            o[d0] = __builtin_amdgcn_mfma_f32_32x32x16_bf16((bf16x8){l1[0], l1[1], l1[2], l1[3], h1[0], h1[1], h1[2], h1[3]}, pa1, o[d0], 0, 0, 0); \
            o[d0] = __builtin_amdgcn_mfma_f32_32x32x16_bf16((bf16x8){l2[0], l2[1], l2[2], l2[3], h2[0], h2[1], h2[2], h2[3]}, pa2, o[d0], 0, 0, 0); \
            o[d0] = __builtin_amdgcn_mfma_f32_32x32x16_bf16((bf16x8){l3[0], l3[1], l3[2], l3[3], h3[0], h3[1], h3[2], h3[3]}, pa3, o[d0], 0, 0, 0); } while (0)
            PV_D0(0); PV_D0(1); PV_D0(2); PV_D0(3);
#undef PV_D0
#undef TRRD
        }
        if (t + 1 < t_hi) ATT_WRITE(buf ^ 1);
        __syncthreads();
    }
#undef ATT_LOAD
#undef ATT_WRITE
    float l_tot;
    { auto rr = __builtin_amdgcn_permlane32_swap(__float_as_uint(l_run), __float_as_uint(l_run), false, false);
      l_tot = __uint_as_float(rr[0]) + __uint_as_float(rr[1]); }
    bf16* orow = O + (size_t)(seqbase + tq) * D + OOFF + h * HD + 4 * hi;
    float* mlp = ML + ((size_t)(seqbase + tq) * 16 + h) * 2;
    float wa = 0.f, wb;
    if constexpr (MODE == 0 && CFG > 0) {
        const float m_o = mlp[0], l_o = mlp[1];
        const float mx = fmaxf(m_o, m_run);
        const float a = l_o * __builtin_amdgcn_exp2f(m_o - mx), a2 = __builtin_amdgcn_exp2f(m_run - mx);
        const float Lt = a + a2 * l_tot, inv = 1.0f / Lt;
        wa = a * inv; wb = a2 * inv;
        if (CFG == 1 && hi == 0) { mlp[0] = mx; mlp[1] = Lt; }
    } else {
        wb = 1.0f / l_tot;
        if (MODE == 0 && hi == 0) { mlp[0] = m_run; mlp[1] = l_tot; }
    }
#pragma unroll
    for (int d0 = 0; d0 < 4; ++d0)
#pragma unroll
        for (int rq = 0; rq < 4; ++rq) { v2u* p = (v2u*)(orow + 32 * d0 + 8 * rq);
            float x0 = o[d0][4 * rq] * wb, x1 = o[d0][4 * rq + 1] * wb, x2 = o[d0][4 * rq + 2] * wb, x3 = o[d0][4 * rq + 3] * wb;
            if constexpr (MODE == 0 && CFG > 0) { const v2u old = *p; x0 += wa * bf_lo(old.x); x1 += wa * bf_hi(old.x); x2 += wa * bf_lo(old.y); x3 += wa * bf_hi(old.y); }
            v2u w; w.x = cvtpk(x0, x1); w.y = cvtpk(x2, x3); *p = w; }
}
#undef KSWZ
}

struct Args { const float* in[17]; float* out; unsigned char* ws; int ph_lo, ph_hi; };
static_assert(sizeof(Args) == 17 * 8 + 8 + 8 + 8, "Args has no padding");

template <int CFG>
__device__ __forceinline__ void attn_subphase(Frame& F, const bf16* QKV, bf16* MG, float* ML, const float* relbias) {
    const int x = blockIdx.x & 7, jl = blockIdx.x >> 3;
    for (int i = 0; i < 6; ++i) {
        const int u = x * 192 + jl + 32 * i; int s, h, j, T, sb;
        if (u < 1024) { s = u >> 9; h = (u >> 5) & 15; j = u & 31; T = 8192; sb = s * 8192; }
        else { const int v = u - 1024; s = v >> 8; h = (v >> 4) & 15; j = v & 15; T = 4096; sb = MP + s * 4096; }
        att::unit<0, CFG>(QKV, MG, ML, relbias, F.lds + RING_OFF, sb, T, h, j);
    }
    for (int i = 0; i < 2; ++i) {
        const int u = 512 * CFG + x * 64 + jl + 32 * i; int s, h, j, T, sb;
        if (u < 1024) { s = u >> 9; h = (u >> 5) & 15; j = u & 31; T = 8192; sb = s * 8192; }
        else { const int v = u - 1024; s = v >> 8; h = (v >> 4) & 15; j = v & 15; T = 4096; sb = MP + s * 4096; }
        att::unit<1, 0>(QKV, MG, ML, relbias, F.lds + RING_OFF, sb, T, h, j);
    }
}

__global__ void __launch_bounds__(NWAVES * 64, 2) mega_fwd(Args args) {
    extern __shared__ __attribute__((aligned(16))) unsigned char lds[];
    Frame F;
    F.lds = (LAS unsigned char*)lds;
    F.MISC = (volatile LAS unsigned*)(F.lds + MISC_OFF);
    F.tid = threadIdx.x; F.lane = F.tid & 63; F.wave = __builtin_amdgcn_readfirstlane(F.tid >> 6);
    F.G = gridDim.x; { const int bx = blockIdx.x; F.vcu = (F.G % 8 == 0) ? (bx % 8) * (F.G / 8) + bx / 8 : bx; }
    unsigned char* ws = args.ws;
    F.ctl = (gu32*)(ws + WS_CTL);
    for (int u = F.tid; u < (LDS_BYTES - LDSCTL_OFF) / 4; u += NWAVES * 64) ((LAS unsigned*)(F.lds + LDSCTL_OFF))[u] = 0u;
    __syncthreads();
    XcdBarrier bar; bar.bar = (unsigned*)(F.ctl + CW_BAR); bar.x = 0; bar.st = nullptr;
    if (MK_N_LAUNCHES == 1) bar = xcd_barrier_post((unsigned*)(F.ctl + CW_BAR), F.MISC + 8);
    const int lo = args.ph_lo, hi = args.ph_hi;
#define IN(k) (lo <= (k) && (k) < hi)
#define SEAM(k) do { if (IN(k) && IN((k) + 1)) xcd_barrier(bar); } while (0)

    const float* x_p = args.in[0]; const float* x_s = args.in[1];
    float* out = args.out;
    bf16* Wgu1 = (bf16*)(ws + WS_WGU1); bf16* Wd1 = (bf16*)(ws + WS_WD1); bf16* Wgu2 = (bf16*)(ws + WS_WGU2); bf16* Wd2 = (bf16*)(ws + WS_WD2);
    bf16* Wqkv = (bf16*)(ws + WS_WQKV); bf16* Wo = (bf16*)(ws + WS_WO);
    bf16* R = (bf16*)(ws + WS_XN); bf16* MG = (bf16*)(ws + WS_MG); bf16* BIG = (bf16*)(ws + WS_BIG);
    float* SS = (float*)(ws + WS_SS);
    float* ROPE = (float*)(ws + WS_ROPE); float* ML = (float*)(ws + WS_ML);
    const int gw = F.vcu * NWAVES + F.wave, NGW = F.G * NWAVES;

    if (IN(0)) {
        constexpr int I_G = (D / 64) * (FF / 64), I_D = (FF / 64) * (D / 64), I_QKV = (D / 64) * (NQKV / 64), I_O = (D / 64) * (D / 64);
        constexpr int NITEMS = 6 * I_G + I_QKV + I_O;
        for (int it = gw; it < NITEMS; it += NGW) {
            int r = it;
            if (r < I_G) { tr_item(args.in[3], D, FF, Wgu1, 1, args.in[2], r, F.lane); continue; } r -= I_G;
            if (r < I_G) { tr_item(args.in[4], D, FF, Wgu1, 2, args.in[2], r, F.lane); continue; } r -= I_G;
            if (r < I_D) { tr_item(args.in[5], FF, D, Wd1, 0, nullptr, r, F.lane); continue; } r -= I_D;
            if (r < I_QKV) { tr_item(args.in[7], D, NQKV, Wqkv, 0, args.in[6], r, F.lane); continue; } r -= I_QKV;
            if (r < I_O) { tr_item(args.in[11], D, D, Wo, 0, nullptr, r, F.lane); continue; } r -= I_O;
            if (r < I_G) { tr_item(args.in[13], D, FF, Wgu2, 1, args.in[12], r, F.lane); continue; } r -= I_G;
            if (r < I_G) { tr_item(args.in[14], D, FF, Wgu2, 2, args.in[12], r, F.lane); continue; } r -= I_G;
            tr_item(args.in[15], FF, D, Wd2, 0, nullptr, r, F.lane);
        }
        for (int e = blockIdx.x * (NWAVES * 64) + F.tid; e < 8192 * 16; e += F.G * NWAVES * 64) {
            const int pos = e >> 4, i = e & 15;
            const float inv = powf(500000.0f, -(float)(2 * i) / 32.0f);
            const float ang = (float)pos * inv;
            const double rev = (double)ang * 0.15915494309189535;
            const float fr = (float)(rev - rint(rev));
            ROPE[2 * e] = __builtin_amdgcn_cosf(fr); ROPE[2 * e + 1] = __builtin_amdgcn_sinf(fr);
        }
        for (int m = gw; m < M; m += NGW) cvt_row_to_bf16(m < MP ? x_p + (size_t)m * D : x_s + (size_t)(m - MP) * D, R + (size_t)m * D, SS + m, F.lane);
    }
    SEAM(0);
    if (IN(1)) {
        pg8::Gemm g{R, Wgu1, M, NGU, D}; pg8::StaticOrder S; S.init(M, NGU, F.G, (int)blockIdx.x);
        pg8::EpiSwiGLU E{BIG, FF, SS};
        pg8::gemm_phase<pg8::EpiSwiGLU, pg8::StaticOrder, true, true>(F.lds + RING_OFF, g, S, E);
    }
    SEAM(1);
    if (IN(2)) {
        pg8::Gemm g{BIG, Wd1, M, D, FF}; pg8::StaticOrder S; S.init(M, D, F.G, (int)blockIdx.x);
        pg8::EpiResBf<false> E{R, nullptr, 0.5f, SS + M};
        pg8::gemm_phase<pg8::EpiResBf<false>, pg8::StaticOrder, true, true>(F.lds + RING_OFF, g, S, E);
    }
    SEAM(2);
    if (IN(3)) {
        pg8::Gemm g{R, Wqkv, M, NQKV, D}; pg8::StaticOrder S; S.init(M, NQKV, F.G, (int)blockIdx.x);
        pg8::EpiQKV E{BIG, NQKV, ROPE, SS + M};
        pg8::gemm_phase<pg8::EpiQKV, pg8::StaticOrder, true, true>(F.lds + RING_OFF, g, S, E);
    }
    SEAM(3);
    if (IN(4)) attn_subphase<0>(F, BIG, MG, ML, args.in[8]);
    SEAM(4);
    if (IN(5)) attn_subphase<1>(F, BIG, MG, ML, args.in[8]);
    SEAM(5);
    if (IN(6)) attn_subphase<2>(F, BIG, MG, ML, args.in[8]);
    SEAM(6);
    if (IN(7)) {
        const float* ga = args.in[9]; const float* gb = args.in[10];
        for (int m = gw; m < M; m += NGW) {
            v4u* rp = (v4u*)(MG + (size_t)m * D) + F.lane; v4u v[8]; float sa = 0.f, sb = 0.f;
#pragma unroll
            for (int j = 0; j < 8; ++j) { v[j] = rp[64 * j]; const float q = (bf_lo(v[j].x) * bf_lo(v[j].x) + bf_hi(v[j].x) * bf_hi(v[j].x)) + (bf_lo(v[j].y) * bf_lo(v[j].y) + bf_hi(v[j].y) * bf_hi(v[j].y))
                    + (bf_lo(v[j].z) * bf_lo(v[j].z) + bf_hi(v[j].z) * bf_hi(v[j].z)) + (bf_lo(v[j].w) * bf_lo(v[j].w) + bf_hi(v[j].w) * bf_hi(v[j].w)); if (j < 4) sa += q; else sb += q; }
            const float ra = 1.0f / sqrtf(wave_sum(sa) * (1.f / WA) + NORM_EPS), rb = 1.0f / sqrtf(wave_sum(sb) * (1.f / WA) + NORM_EPS);
#pragma unroll
            for (int j = 0; j < 8; ++j) { const float r = (j < 4) ? ra : rb; const float* gp = ((j < 4) ? ga : gb) + 8 * F.lane + 512 * (j & 3);
                const f32x4 g0 = *(const f32x4*)gp, g1 = *(const f32x4*)(gp + 4); v4u w;
                w.x = cvtpk(bf_lo(v[j].x) * r * g0.x, bf_hi(v[j].x) * r * g0.y); w.y = cvtpk(bf_lo(v[j].y) * r * g0.z, bf_hi(v[j].y) * r * g0.w);
                w.z = cvtpk(bf_lo(v[j].z) * r * g1.x, bf_hi(v[j].z) * r * g1.y); w.w = cvtpk(bf_lo(v[j].w) * r * g1.z, bf_hi(v[j].w) * r * g1.w);
                rp[64 * j] = w; }
        }
    }
    SEAM(7);
    if (IN(8)) {
        pg8::Gemm g{MG, Wo, M, D, D}; pg8::StaticOrder S; S.init(M, D, F.G, (int)blockIdx.x);
        pg8::EpiResBf<false> E{R, nullptr, 1.0f, SS + 2 * M};
        pg8::gemm_phase<pg8::EpiResBf<false>, pg8::StaticOrder, true, true>(F.lds + RING_OFF, g, S, E);
    }
    SEAM(8);
    if (IN(9)) {
        pg8::Gemm g{R, Wgu2, M, NGU, D}; pg8::StaticOrder S; S.init(M, NGU, F.G, (int)blockIdx.x);
        pg8::EpiSwiGLU E{BIG, FF, SS + 2 * M};
        pg8::gemm_phase<pg8::EpiSwiGLU, pg8::StaticOrder, true, true>(F.lds + RING_OFF, g, S, E);
    }
    SEAM(9);
    if (IN(10)) {
        pg8::Gemm g{BIG, Wd2, M, D, FF}; pg8::StaticOrder S; S.init(M, D, F.G, (int)blockIdx.x);
        pg8::EpiResBf<true> E{R, out, 0.5f, SS + 3 * M};
        pg8::gemm_phase<pg8::EpiResBf<true>, pg8::StaticOrder, true, true>(F.lds + RING_OFF, g, S, E);
    }
    SEAM(10);
    if (IN(11)) {
        const float* gfin = args.in[16];
        unsigned bad = (__hip_atomic_load(F.ctl + CW_BAR + XB_TMO, RLX_AGENT) != 0u);
        const f32x4* gr = (const f32x4*)gfin + F.lane; f32x4 gg[16];
#pragma unroll
        for (int j = 0; j < 16; ++j) gg[j] = gr[64 * j];
        for (int m = gw; m < M; m += NGW) {
            f32x4* xr = (f32x4*)(out + (size_t)m * D) + F.lane;
            float r = __builtin_amdgcn_rsqf(SS[3 * M + m] * (1.f / D) + NORM_EPS);
            if (bad) r = __builtin_nanf("");
            f32x4 v[16];
#pragma unroll
            for (int j = 0; j < 16; ++j) v[j] = xr[64 * j];
#pragma unroll
            for (int j = 0; j < 16; ++j) xr[64 * j] = v[j] * r * gg[j];
        }
    }
#undef IN
#undef SEAM
}

extern "C" void kernel_launch(void* const* d_in, const int* in_sizes, int n_in, void* d_out, int out_size, void* d_ws, size_t ws_size, hipStream_t stream) {
    static int grid = 0;
    if (grid == 0) {
        if (n_in != 17 || in_sizes[0] != MP * D || in_sizes[1] != MS * D || out_size != M * D || ws_size < WS_END) {
            fprintf(stderr, "kernel_launch: unexpected shapes (n_in %d, in0 %d, in1 %d, out %d, ws %zu < %zu); nothing launched\n", n_in, n_in > 0 ? in_sizes[0] : -1, n_in > 1 ? in_sizes[1] : -1, out_size, ws_size, (size_t)WS_END);
            grid = -1; return; }
        int dev = 0, cus = 0, per_cu = 0;
        if (hipGetDevice(&dev) != hipSuccess || hipDeviceGetAttribute(&cus, hipDeviceAttributeMultiprocessorCount, dev) != hipSuccess) { grid = -1; return; }
        if (hipFuncSetAttribute((const void*)mega_fwd, hipFuncAttributeMaxDynamicSharedMemorySize, LDS_BYTES) != hipSuccess) { fprintf(stderr, "kernel_launch: hipFuncSetAttribute failed\n"); grid = -1; return; }
        if (hipOccupancyMaxActiveBlocksPerMultiprocessor(&per_cu, (const void*)mega_fwd, NWAVES * 64, LDS_BYTES) != hipSuccess || per_cu < 1)
            fprintf(stderr, "kernel_launch: note: occupancy query reports %d workgroups per CU\n", per_cu);
        (void)hipGetLastError();
        grid = cus;
        if (grid != 256) fprintf(stderr, "kernel_launch: note: %d CUs\n", grid);
    }
    if (grid < 0) return;
    if (hipMemsetAsync((char*)d_ws + WS_CTL, 0, CTL_ZERO_BYTES, stream) != hipSuccess) { fprintf(stderr, "kernel_launch: memset failed\n"); return; }
    Args a{};
    for (int i = 0; i < 17; ++i) a.in[i] = (const float*)d_in[i];
    a.out = (float*)d_out; a.ws = (unsigned char*)d_ws;
#if MK_N_LAUNCHES == 1
    a.ph_lo = 0; a.ph_hi = N_PHASES;
    hipLaunchKernelGGL(mega_fwd, dim3(grid), dim3(NWAVES * 64), LDS_BYTES, stream, a);
#else
    for (int p = 0; p < N_PHASES; ++p) { a.ph_lo = p; a.ph_hi = p + 1; hipLaunchKernelGGL(mega_fwd, dim3(grid), dim3(NWAVES * 64), LDS_BYTES, stream, a); }
#endif
    const hipError_t le = hipPeekAtLastError();
    if (le != hipSuccess) fprintf(stderr, "kernel_launch: launch failed: %s\n", hipGetErrorName(le));
}
```
